# Optimizing an MI355X kernel written in HIP

```python
import math
import jax, jax.numpy as jnp
from jax import lax
import numpy as np

D_MODEL = 4096
BATCH = 2
SEQ = 8192
DEPTH = 1

PLE_DIM = 256
CONV_WIDTH = D_MODEL
CONV_GROUP = 128
N_HEADS = 32
HEAD_DIM = 128
ATTN_WIDTH = N_HEADS * HEAD_DIM
SHORT_K = 3
D_FF = ((8 * D_MODEL // 3 + 255) // 256) * 256
Q_BLOCK = 128
EPS = 1e-6
IN_SPLITS = [CONV_WIDTH, CONV_WIDTH, CONV_WIDTH,
             ATTN_WIDTH, ATTN_WIDTH, ATTN_WIDTH,
             N_HEADS, D_MODEL, D_MODEL]
IN_COLS = sum(IN_SPLITS)
IN_OFFSETS = [int(v) for v in np.cumsum(IN_SPLITS)[:-1]]
NEG_INF = -1e30

kernel_name = "hybrid_gated_conv_fox_block"


def rms_norm(x, g):
    xf = x.astype(jnp.float32)
    inv = lax.rsqrt(jnp.mean(xf * xf, axis=-1, keepdims=True) + EPS)
    return (xf * inv * g.astype(jnp.float32)).astype(x.dtype)


def causal_dwconv3(u, w, b=None):
    up = jnp.pad(u, ((0, 0), (SHORT_K - 1, 0), (0, 0)))
    s = u.shape[1]
    y = w[0] * up[:, 0:s] + w[1] * up[:, 1:s + 1] + w[2] * up[:, 2:s + 2]
    if b is not None:
        y = y + b
    return y


def fox_attention(q, k, v, log_f):
    b, s, h, dh = q.shape
    nb = s // Q_BLOCK
    scale = 1.0 / math.sqrt(dh)
    c = jnp.cumsum(log_f, axis=1)
    c_kT = jnp.transpose(c, (0, 2, 1))
    q_blocks = jnp.transpose(q.reshape(b, nb, Q_BLOCK, h, dh), (1, 0, 2, 3, 4))
    c_blocks = jnp.transpose(c.reshape(b, nb, Q_BLOCK, h), (1, 0, 3, 2))
    k_pos = jnp.arange(s)

    def one_block(args):
        i, q_i, c_i = args
        logits = jnp.einsum('bqhd,bkhd->bhqk', q_i, k,
                            preferred_element_type=jnp.float32) * scale
        logits = logits + c_i[..., :, None] - c_kT[:, :, None, :]
        q_pos = i * Q_BLOCK + jnp.arange(Q_BLOCK)
        mask = k_pos[None, :] <= q_pos[:, None]
        logits = jnp.where(mask[None, None], logits, NEG_INF)
        probs = jax.nn.softmax(logits, axis=-1)
        return jnp.einsum('bhqk,bkhd->bqhd', probs.astype(v.dtype), v)

    out = lax.map(one_block, (jnp.arange(nb), q_blocks, c_blocks))
    return jnp.transpose(out, (1, 0, 2, 3, 4)).reshape(b, s, h, dh)


def setup_inputs(seed: int = 0) -> dict:
    key = jax.random.key(seed)
    ks = jax.random.split(key, 24)
    f32 = jnp.float32

    def dense(k, fan_in, fan_out):
        return jax.random.normal(k, (DEPTH, fan_in, fan_out), f32) * (fan_in ** -0.5)

    def gain(k, n):
        return 1.0 + 0.02 * jax.random.normal(k, (DEPTH, n), f32)

    x = jax.random.normal(ks[0], (BATCH, SEQ, D_MODEL), f32)
    p = jax.random.normal(ks[1], (DEPTH, BATCH, SEQ, PLE_DIM), f32)
    forget_bias = jax.random.uniform(ks[4], (DEPTH, N_HEADS), f32, 1.0, 6.0)
    return {
        "x": x,
        "p": p,
        "norm_mix_pre": gain(ks[2], D_MODEL),
        "w_in": dense(ks[3], D_MODEL, IN_COLS),
        "forget_bias": forget_bias,
        "conv_mix_w": jax.random.normal(ks[5], (DEPTH, SHORT_K, CONV_WIDTH), f32) * (SHORT_K ** -0.5),
        "w_branch_conv": dense(ks[6], CONV_WIDTH, D_MODEL),
        "w_branch_attn": dense(ks[7], ATTN_WIDTH, D_MODEL),
        "w_out": dense(ks[8], D_MODEL, D_MODEL),
        "norm_mix_post": gain(ks[9], D_MODEL),
        "norm_ffn_pre": gain(ks[10], D_MODEL),
        "w_up": dense(ks[11], D_MODEL, 2 * D_FF),
        "ffn_conv_w": jax.random.normal(ks[12], (DEPTH, SHORT_K, 2 * D_FF), f32) * (SHORT_K ** -0.5),
        "ffn_conv_b": 0.02 * jax.random.normal(ks[13], (DEPTH, 2 * D_FF), f32),
        "w_down": dense(ks[14], D_FF, D_MODEL),
        "norm_ffn_post": gain(ks[15], D_MODEL),
        "w_ple_proj": dense(ks[16], PLE_DIM, D_MODEL),
        "norm_ple_gate": gain(ks[17], D_MODEL),
        "w_ple_gate": dense(ks[18], D_MODEL, D_MODEL),
        "norm_ple_post": gain(ks[19], D_MODEL),
    }


def reference(x, p, norm_mix_pre, w_in, forget_bias, conv_mix_w, w_branch_conv,
              w_branch_attn, w_out, norm_mix_post, norm_ffn_pre, w_up, ffn_conv_w,
              ffn_conv_b, w_down, norm_ffn_post, w_ple_proj, norm_ple_gate,
              w_ple_gate, norm_ple_post):
    b, s, _ = x.shape
    for i in range(DEPTH):
        h = rms_norm(x, norm_mix_pre[i])
        z = h @ w_in[i]
        c_b, c_c, c_v, q, k, v, f_logit, g_a, g_b = jnp.split(z, IN_OFFSETS, axis=-1)

        conv_out = causal_dwconv3(c_c * c_v, conv_mix_w[i])
        y_a = (c_b * conv_out) @ w_branch_conv[i]

        log_f = jax.nn.log_sigmoid(f_logit.astype(jnp.float32)
                                   + forget_bias[i].astype(jnp.float32))
        o = fox_attention(q.reshape(b, s, N_HEADS, HEAD_DIM),
                          k.reshape(b, s, N_HEADS, HEAD_DIM),
                          v.reshape(b, s, N_HEADS, HEAD_DIM), log_f)
        y_b = o.reshape(b, s, ATTN_WIDTH) @ w_branch_attn[i]

        merged = jax.nn.sigmoid(g_a) * y_a + jax.nn.sigmoid(g_b) * y_b
        x = x + rms_norm(merged @ w_out[i], norm_mix_post[i])

        h = rms_norm(x, norm_ffn_pre[i])
        u = causal_dwconv3(h @ w_up[i], ffn_conv_w[i], ffn_conv_b[i])
        u_gate, u_val = jnp.split(u, 2, axis=-1)
        ffn = (jax.nn.gelu(u_gate, approximate=True) * u_val) @ w_down[i]
        x = x + rms_norm(ffn, norm_ffn_post[i])

        e = p[i] @ w_ple_proj[i]
        gate = jax.nn.sigmoid(rms_norm(x, norm_ple_gate[i]) @ w_ple_gate[i])
        x = x + rms_norm(gate * e, norm_ple_post[i])
    return x
```

```cpp
#include <hip/hip_runtime.h>
#include <cstdio>
#include <cstdint>
#ifndef MK_PER_PHASE
#define MK_PER_PHASE 0
#endif
namespace pg8 {
#define PG8_LAS __attribute__((address_space(3)))
typedef unsigned short bf16_t;
typedef short bf16x8 __attribute__((ext_vector_type(8)));
typedef float f32x4 __attribute__((ext_vector_type(4)));
typedef unsigned u32x4 __attribute__((ext_vector_type(4)));
constexpr int BM = 256, BK = 64, HALF = 128, HTB = HALF * BK * 2  , STAGE_BYTES = 8 * HTB, NXCD = 8, WGM = 8;

__host__ __device__ __forceinline__ int lds_byte(int r, int c) { const int st = (r >> 4) * 2 + (c >> 5), rr = r & 15, cc = c & 31, ob = rr * 64 + cc * 2; return st * 1024 + (ob ^ (((ob >> 9) & 1) << 5)); }
__host__ __device__ __forceinline__ void stage_rc(int b, int& R, int& C) { const int st = b / 1024, sb = b % 1024, swz = sb ^ (((sb >> 9) & 1) << 5); R = (st >> 1) * 16 + swz / 64; C = (st & 1) * 32 + (swz % 64) / 2; }
__host__ __device__ __forceinline__ int perm32(int rho) { const int n = rho >> 4, i = rho & 15; return 8 * (i >> 2) + 4 * n + (i & 3); }

struct Unit { int pm, pn; };
struct Gemm { const bf16_t* A; const bf16_t* Bt; int M, N, K; };

struct StaticOrder {
    int nM, nN, nwg, G, c;
    __host__ __device__ void init(int M, int N, int G_, int c_) { nM = M / BM; nN = N / BM; nwg = nM * nN; G = G_; c = c_; }
    __host__ __device__ bool next(int i, Unit& u) const {
        const long L = (long)i * G + c; if (L >= nwg) return false;
        int wgid = (int)L; { const int q = nwg / NXCD, r = nwg % NXCD, xcd = wgid % NXCD, off = wgid / NXCD; wgid = (xcd < r ? xcd * (q + 1) : r * (q + 1) + (xcd - r) * q) + off; }
        const int nig = WGM * nN, gid = wgid / nig, fm = gid * WGM, gsz = (nM - fm) < WGM ? (nM - fm) : WGM;
        u.pm = fm + ((wgid % nig) % gsz); u.pn = (wgid % nig) / gsz; return true;
    }
    __device__ __forceinline__ void a_ready(const Unit&) const {}
    __device__ __forceinline__ void done(const Unit&) const {}
};

__device__ __forceinline__ unsigned cvt_pk_bf16(float lo, float hi) { unsigned r; asm volatile("v_cvt_pk_bf16_f32 %0, %1, %2" : "=v"(r) : "v"(lo), "v"(hi)); return r; }
__device__ __forceinline__ float fast_sigmoid(float x) { return __builtin_amdgcn_rcpf(1.0f + __builtin_amdgcn_exp2f(-1.4426950408889634f * x)); }
__device__ __forceinline__ float bf_lo(unsigned w) { return __uint_as_float(w << 16); }
__device__ __forceinline__ float bf_hi(unsigned w) { return __uint_as_float(w & 0xffff0000u); }
__device__ __forceinline__ u32x4 pack8(const f32x4 v0, const f32x4 v1) { u32x4 w; w.x = cvt_pk_bf16(v0[0], v0[1]); w.y = cvt_pk_bf16(v0[2], v0[3]); w.z = cvt_pk_bf16(v1[0], v1[1]); w.w = cvt_pk_bf16(v1[2], v1[3]); return w; }

struct EpiPlain {
    static constexpr bool PERM = true, AFTER_DRAIN = false;
    bf16_t* O; int ldc;
    __device__ __forceinline__ void operator()(const f32x4 (&acc)[2][2][4][2], const Unit& u, int wr, int wc, int fr, int fq) const {
        const int row0 = u.pm * BM + wr * 64 + fr, col0 = u.pn * BM + wc * 32 + 8 * fq;
#pragma unroll
        for (int ai = 0; ai < 2; ++ai)
#pragma unroll
            for (int m = 0; m < 4; ++m) { bf16_t* rowp = O + (size_t)(row0 + ai * HALF + m * 16) * ldc + col0;
#pragma unroll
                for (int bj = 0; bj < 2; ++bj) *(u32x4*)(rowp + bj * HALF) = pack8(acc[ai][bj][m][0], acc[ai][bj][m][1]); }
    }
};
struct EpiZ {
    static constexpr bool PERM = true, AFTER_DRAIN = false;
    bf16_t* Z; int ldz; int nzt; float* FLT; int M;
    __device__ __forceinline__ void operator()(const f32x4 (&acc)[2][2][4][2], const Unit& u, int wr, int wc, int fr, int fq) const {
        const int row0 = u.pm * BM + wr * 64 + fr;
        if (u.pn < nzt) {
            const int col0 = u.pn * BM + wc * 32 + 8 * fq;
#pragma unroll
            for (int ai = 0; ai < 2; ++ai)
#pragma unroll
                for (int m = 0; m < 4; ++m) { bf16_t* rowp = Z + (size_t)(row0 + ai * HALF + m * 16) * ldz + col0;
#pragma unroll
                    for (int bj = 0; bj < 2; ++bj) *(u32x4*)(rowp + bj * HALF) = pack8(acc[ai][bj][m][0], acc[ai][bj][m][1]); }
        } else if (wc == 0) {
#pragma unroll
            for (int ai = 0; ai < 2; ++ai)
#pragma unroll
                for (int m = 0; m < 4; ++m) { const int row = row0 + ai * HALF + m * 16;
#pragma unroll
                    for (int n = 0; n < 2; ++n)
#pragma unroll
                        for (int j = 0; j < 4; ++j) FLT[(size_t)(8 * fq + 4 * n + j) * M + row] = acc[ai][0][m][n][j]; }
        }
    }
};
struct EpiGateA {
    static constexpr bool PERM = true, AFTER_DRAIN = false;
    float* MA; int ldc; const bf16_t* G; int ldg;
    __device__ __forceinline__ void operator()(const f32x4 (&acc)[2][2][4][2], const Unit& u, int wr, int wc, int fr, int fq) const {
        const int row0 = u.pm * BM + wr * 64 + fr, col0 = u.pn * BM + wc * 32 + 8 * fq;
#pragma unroll
        for (int ai = 0; ai < 2; ++ai)
#pragma unroll
            for (int m = 0; m < 4; ++m) { const size_t row = (size_t)(row0 + ai * HALF + m * 16);
#pragma unroll
                for (int bj = 0; bj < 2; ++bj) { const u32x4 g = *(const u32x4*)(G + row * ldg + col0 + bj * HALF);
                    f32x4 v0 = acc[ai][bj][m][0], v1 = acc[ai][bj][m][1];
                    v0[0] *= fast_sigmoid(bf_lo(g.x)); v0[1] *= fast_sigmoid(bf_hi(g.x)); v0[2] *= fast_sigmoid(bf_lo(g.y)); v0[3] *= fast_sigmoid(bf_hi(g.y));
                    v1[0] *= fast_sigmoid(bf_lo(g.z)); v1[1] *= fast_sigmoid(bf_hi(g.z)); v1[2] *= fast_sigmoid(bf_lo(g.w)); v1[3] *= fast_sigmoid(bf_hi(g.w));
                    float* o = MA + row * ldc + col0 + bj * HALF; *(f32x4*)o = v0; *(f32x4*)(o + 4) = v1; } }
    }
};
struct EpiGateB {
    static constexpr bool PERM = true, AFTER_DRAIN = false;
    bf16_t* MM; const float* MA; int ldc; const bf16_t* G; int ldg;
    __device__ __forceinline__ void operator()(const f32x4 (&acc)[2][2][4][2], const Unit& u, int wr, int wc, int fr, int fq) const {
        const int row0 = u.pm * BM + wr * 64 + fr, col0 = u.pn * BM + wc * 32 + 8 * fq;
#pragma unroll
        for (int ai = 0; ai < 2; ++ai)
#pragma unroll
            for (int m = 0; m < 4; ++m) { const size_t row = (size_t)(row0 + ai * HALF + m * 16);
#pragma unroll
                for (int bj = 0; bj < 2; ++bj) { const u32x4 g = *(const u32x4*)(G + row * ldg + col0 + bj * HALF);
                    const float* a = MA + row * ldc + col0 + bj * HALF; const f32x4 a0 = *(const f32x4*)a, a1 = *(const f32x4*)(a + 4);
                    f32x4 v0 = acc[ai][bj][m][0], v1 = acc[ai][bj][m][1];
                    v0[0] = a0[0] + v0[0] * fast_sigmoid(bf_lo(g.x)); v0[1] = a0[1] + v0[1] * fast_sigmoid(bf_hi(g.x)); v0[2] = a0[2] + v0[2] * fast_sigmoid(bf_lo(g.y)); v0[3] = a0[3] + v0[3] * fast_sigmoid(bf_hi(g.y));
                    v1[0] = a1[0] + v1[0] * fast_sigmoid(bf_lo(g.z)); v1[1] = a1[1] + v1[1] * fast_sigmoid(bf_hi(g.z)); v1[2] = a1[2] + v1[2] * fast_sigmoid(bf_lo(g.w)); v1[3] = a1[3] + v1[3] * fast_sigmoid(bf_hi(g.w));
                    *(u32x4*)(MM + row * ldc + col0 + bj * HALF) = pack8(v0, v1); } }
    }
};
struct EpiSS {
    static constexpr bool PERM = true, AFTER_DRAIN = false;
    bf16_t* W; int ldc; float* SSP; int nslot; const float* gain;
    __device__ __forceinline__ void operator()(const f32x4 (&acc)[2][2][4][2], const Unit& u, int wr, int wc, int fr, int fq) const {
        const int row0 = u.pm * BM + wr * 64 + fr, col0 = u.pn * BM + wc * 32 + 8 * fq;
        f32x4 gv[2][2];
#pragma unroll
        for (int bj = 0; bj < 2; ++bj) { gv[bj][0] = *(const f32x4*)(gain + col0 + bj * HALF); gv[bj][1] = *(const f32x4*)(gain + col0 + bj * HALF + 4); }
#pragma unroll
        for (int ai = 0; ai < 2; ++ai)
#pragma unroll
            for (int m = 0; m < 4; ++m) { const size_t row = (size_t)(row0 + ai * HALF + m * 16); float s = 0.f;
#pragma unroll
                for (int bj = 0; bj < 2; ++bj) { const f32x4 v0 = acc[ai][bj][m][0], v1 = acc[ai][bj][m][1];
                    s += (v0[0] * v0[0] + v0[1] * v0[1]) + (v0[2] * v0[2] + v0[3] * v0[3]) + (v1[0] * v1[0] + v1[1] * v1[1]) + (v1[2] * v1[2] + v1[3] * v1[3]);
                    *(u32x4*)(W + row * ldc + col0 + bj * HALF) = pack8(v0 * gv[bj][0], v1 * gv[bj][1]); }
                s += __shfl_xor(s, 16); s += __shfl_xor(s, 32);
                if (fq == 0) SSP[row * nslot + 4 * u.pn + wc] = s; }
    }
};
struct EpiPle {
    static constexpr bool PERM = true, AFTER_DRAIN = false;
    bf16_t* GE; int ldc; const bf16_t* E; float* SSP; int nslot; const float* gain;
    __device__ __forceinline__ void operator()(const f32x4 (&acc)[2][2][4][2], const Unit& u, int wr, int wc, int fr, int fq) const {
        const int row0 = u.pm * BM + wr * 64 + fr, col0 = u.pn * BM + wc * 32 + 8 * fq;
        f32x4 gv[2][2];
#pragma unroll
        for (int bj = 0; bj < 2; ++bj) { gv[bj][0] = *(const f32x4*)(gain + col0 + bj * HALF); gv[bj][1] = *(const f32x4*)(gain + col0 + bj * HALF + 4); }
#pragma unroll
        for (int ai = 0; ai < 2; ++ai)
#pragma unroll
            for (int m = 0; m < 4; ++m) { const size_t row = (size_t)(row0 + ai * HALF + m * 16); float s = 0.f;
#pragma unroll
                for (int bj = 0; bj < 2; ++bj) { const u32x4 e = *(const u32x4*)(E + row * ldc + col0 + bj * HALF);
                    f32x4 v0 = acc[ai][bj][m][0], v1 = acc[ai][bj][m][1];
                    v0[0] = fast_sigmoid(v0[0]) * bf_lo(e.x); v0[1] = fast_sigmoid(v0[1]) * bf_hi(e.x); v0[2] = fast_sigmoid(v0[2]) * bf_lo(e.y); v0[3] = fast_sigmoid(v0[3]) * bf_hi(e.y);
                    v1[0] = fast_sigmoid(v1[0]) * bf_lo(e.z); v1[1] = fast_sigmoid(v1[1]) * bf_hi(e.z); v1[2] = fast_sigmoid(v1[2]) * bf_lo(e.w); v1[3] = fast_sigmoid(v1[3]) * bf_hi(e.w);
                    s += (v0[0] * v0[0] + v0[1] * v0[1]) + (v0[2] * v0[2] + v0[3] * v0[3]) + (v1[0] * v1[0] + v1[1] * v1[1]) + (v1[2] * v1[2] + v1[3] * v1[3]);
                    *(u32x4*)(GE + row * ldc + col0 + bj * HALF) = pack8(v0 * gv[bj][0], v1 * gv[bj][1]); }
                s += __shfl_xor(s, 16); s += __shfl_xor(s, 32);
                if (fq == 0) SSP[row * nslot + 4 * u.pn + wc] = s; }
    }
};
template <class Epi, class Sched, bool ALIGN_EPI = false, bool SP2 = false>
__device__ __forceinline__ void gemm_phase(PG8_LAS unsigned char* lds, const Gemm g, const Sched& S, const Epi& E) {
    const int tid = threadIdx.x, wid = __builtin_amdgcn_readfirstlane(tid >> 6), lane = tid & 63, wr = wid >> 2, wc = wid & 3, fr = lane & 15, fq = lane >> 4;
    const int K = g.K, nt = K / BK;
    unsigned voffA[2], voffB[2];
#pragma unroll
    for (int i = 0; i < 2; ++i) { int R, C; stage_rc(tid * 16 + i * 8192, R, C); const int Rb = Epi::PERM ? ((R & ~31) + perm32(R & 31)) : R;
        voffA[i] = (unsigned)(R * K + C) * 2u; voffB[i] = (unsigned)(Rb * K + C) * 2u; }
    const size_t kstep = (size_t)(BK * 2);
    const size_t hstep = (size_t)HALF * K * 2;
    const size_t tstep = 2 * hstep;
    const unsigned ldsw = (unsigned)wid * 1024u;
    const int aoff = lds_byte(wr * 64 + fr, fq * 8), boff = lds_byte(wc * 32 + fr, fq * 8);
#define PG8_SA(b, h) (((b) * 2 + (h)) * HTB)
#define PG8_SB(b, h) ((4 + (b) * 2 + (h)) * HTB)
#define PG8_STAGE(bufoff, gbase, voff) do { _Pragma("unroll") for (int _i = 0; _i < 2; ++_i) \
        __builtin_amdgcn_global_load_lds((const unsigned*)((const char*)(gbase) + (voff)[_i]), (PG8_LAS unsigned*)(lds + (bufoff) + ldsw + _i * 8192), 16, 0, 0); } while (0)
#define PG8_LDA(dst, b, h) do { _Pragma("unroll") for (int m = 0; m < 4; ++m) _Pragma("unroll") for (int k = 0; k < 2; ++k) dst[m][k] = *(const PG8_LAS bf16x8*)(lds + PG8_SA(b, h) + aoff + m * 2048 + k * 1024); } while (0)
#define PG8_LDB(dst, b, h) do { _Pragma("unroll") for (int n = 0; n < 2; ++n) _Pragma("unroll") for (int k = 0; k < 2; ++k) dst[n][k] = *(const PG8_LAS bf16x8*)(lds + PG8_SB(b, h) + boff + n * 2048 + k * 1024); } while (0)
#define PG8_MMA(ai, bj, At, Bt) do { __builtin_amdgcn_s_setprio(1); _Pragma("unroll") for (int m = 0; m < 4; ++m) _Pragma("unroll") for (int n = 0; n < 2; ++n) _Pragma("unroll") for (int k = 0; k < 2; ++k) \
        acc[ai][bj][m][n] = __builtin_amdgcn_mfma_f32_16x16x32_bf16(Bt[n][k], At[m][k], acc[ai][bj][m][n], 0, 0, 0); __builtin_amdgcn_s_setprio(0); } while (0)
#define PG8_WAIT_V(n) asm volatile("s_waitcnt vmcnt(" #n ")" ::: "memory")
#define PG8_WAIT_L(n) asm volatile("s_waitcnt lgkmcnt(" #n ")" ::: "memory")
#define PG8_BAR __builtin_amdgcn_s_barrier()
#define PG8_SCHED __builtin_amdgcn_sched_barrier(0)
    Unit cur, nxt; int ui = 0;
    if (!S.next(0, cur)) return;
    f32x4 acc[2][2][4][2];
#pragma unroll
    for (int a = 0; a < 2; ++a)
#pragma unroll
        for (int b = 0; b < 2; ++b)
#pragma unroll
            for (int m = 0; m < 4; ++m)
#pragma unroll
                for (int n = 0; n < 2; ++n) acc[a][b][m][n] = (f32x4){0.f, 0.f, 0.f, 0.f};
    bf16x8 At[4][2], B0[2][2], B1[2][2];
    const char* cA = (const char*)g.A + (size_t)cur.pm * tstep; const char* cB = (const char*)g.Bt + (size_t)cur.pn * tstep;
    S.a_ready(cur);
    if constexpr (SP2) {
        PG8_STAGE(PG8_SB(0, 0), cB, voffB); PG8_STAGE(PG8_SB(0, 1), cB + hstep, voffB); PG8_STAGE(PG8_SA(0, 0), cA, voffA); PG8_STAGE(PG8_SA(0, 1), cA + hstep, voffA);
        if (wr == 1) PG8_BAR;
        PG8_WAIT_V(2); PG8_BAR;
        PG8_STAGE(PG8_SB(1, 0), cB + kstep, voffB); PG8_STAGE(PG8_SA(1, 0), cA + kstep, voffA); PG8_STAGE(PG8_SB(1, 1), cB + hstep + kstep, voffB);
        PG8_WAIT_V(6); PG8_BAR;
    } else {
        PG8_STAGE(PG8_SB(0, 0), cB, voffB); PG8_STAGE(PG8_SA(0, 0), cA, voffA); PG8_STAGE(PG8_SB(0, 1), cB + hstep, voffB); PG8_STAGE(PG8_SA(0, 1), cA + hstep, voffA);
        if (wr == 1) PG8_BAR;
        PG8_WAIT_V(4); PG8_BAR;
        PG8_STAGE(PG8_SB(1, 0), cB + kstep, voffB); PG8_STAGE(PG8_SA(1, 0), cA + kstep, voffA); PG8_STAGE(PG8_SB(1, 1), cB + hstep + kstep, voffB);
        PG8_WAIT_V(6); PG8_BAR;
    }
    for (;;) {
        const bool has_next = S.next(ui + 1, nxt);
        const char* nA = has_next ? (const char*)g.A + (size_t)nxt.pm * tstep : cA; const char* nB = has_next ? (const char*)g.Bt + (size_t)nxt.pn * tstep : cB;
        for (int t = 0; t < nt; t += 2) {
            const bool last = (t == nt - 2);
            const char* a1 = cA + (size_t)(t + 1) * kstep;
            const char* a2 = last ? nA : cA + (size_t)(t + 2) * kstep; const char* b2 = last ? nB : cB + (size_t)(t + 2) * kstep;
            const char* a3 = a2 + kstep; const char* b3 = b2 + kstep;
            if (last && has_next) S.a_ready(nxt);
            if constexpr (SP2) {
            PG8_LDB(B0, 0, 0); PG8_LDB(B1, 0, 1); PG8_SCHED; PG8_LDA(At, 0, 0); PG8_STAGE(PG8_SA(1, 1), a1 + hstep, voffA);
            PG8_WAIT_V(8); PG8_WAIT_L(0); PG8_BAR; PG8_MMA(0, 0, At, B0); PG8_MMA(0, 1, At, B1); PG8_BAR; PG8_SCHED;
            PG8_LDA(At, 0, 1); PG8_STAGE(PG8_SB(0, 0), b2, voffB); PG8_STAGE(PG8_SB(0, 1), b2 + hstep, voffB); PG8_STAGE(PG8_SA(0, 0), a2, voffA);
            PG8_WAIT_V(8); PG8_WAIT_L(0); PG8_BAR; PG8_MMA(1, 0, At, B0); PG8_MMA(1, 1, At, B1); PG8_BAR; PG8_SCHED;
            PG8_LDB(B0, 1, 0); PG8_LDB(B1, 1, 1); PG8_SCHED; PG8_LDA(At, 1, 0); PG8_STAGE(PG8_SA(0, 1), a2 + hstep, voffA);
            PG8_WAIT_V(8); PG8_WAIT_L(0); PG8_BAR; PG8_MMA(0, 0, At, B0); PG8_MMA(0, 1, At, B1); PG8_BAR; PG8_SCHED;
            PG8_LDA(At, 1, 1); PG8_STAGE(PG8_SB(1, 0), b3, voffB); PG8_STAGE(PG8_SB(1, 1), b3 + hstep, voffB); PG8_STAGE(PG8_SA(1, 0), a3, voffA);
            PG8_WAIT_V(8); PG8_WAIT_L(0); PG8_BAR; PG8_MMA(1, 0, At, B0); PG8_MMA(1, 1, At, B1); PG8_BAR; PG8_SCHED;
            } else {
            PG8_LDB(B0, 0, 0); PG8_SCHED; PG8_LDA(At, 0, 0); PG8_STAGE(PG8_SA(1, 1), a1 + hstep, voffA);
            PG8_WAIT_L(8); PG8_BAR; PG8_WAIT_L(0); PG8_MMA(0, 0, At, B0); PG8_BAR; PG8_SCHED;
            PG8_LDB(B1, 0, 1); PG8_STAGE(PG8_SB(0, 0), b2, voffB);
            PG8_BAR; PG8_WAIT_L(0); PG8_MMA(0, 1, At, B1); PG8_BAR;
            PG8_LDA(At, 0, 1); PG8_STAGE(PG8_SA(0, 0), a2, voffA);
            PG8_BAR; PG8_WAIT_L(0); PG8_MMA(1, 0, At, B0); PG8_BAR; PG8_SCHED;
            PG8_STAGE(PG8_SB(0, 1), b2 + hstep, voffB);
            PG8_WAIT_V(6); PG8_BAR; PG8_MMA(1, 1, At, B1); PG8_BAR;
            PG8_LDB(B0, 1, 0); PG8_SCHED; PG8_LDA(At, 1, 0); PG8_STAGE(PG8_SA(0, 1), a2 + hstep, voffA);
            PG8_WAIT_L(8); PG8_BAR; PG8_WAIT_L(0); PG8_MMA(0, 0, At, B0); PG8_BAR; PG8_SCHED;
            PG8_LDB(B1, 1, 1); PG8_STAGE(PG8_SB(1, 0), b3, voffB);
            PG8_BAR; PG8_WAIT_L(0); PG8_MMA(0, 1, At, B1); PG8_BAR;
            PG8_LDA(At, 1, 1); PG8_STAGE(PG8_SA(1, 0), a3, voffA);
            PG8_BAR; PG8_WAIT_L(0); PG8_MMA(1, 0, At, B0); PG8_BAR; PG8_SCHED;
            PG8_STAGE(PG8_SB(1, 1), b3 + hstep, voffB);
            PG8_WAIT_V(6); PG8_BAR; PG8_MMA(1, 1, At, B1); PG8_BAR;
            }
        }
        if constexpr (ALIGN_EPI) { if (wr == 0) PG8_BAR; }
        if constexpr (!Epi::AFTER_DRAIN) { E(acc, cur, wr, wc, fr, fq); S.done(cur); }
        if (!has_next) break;
#pragma unroll
        for (int a = 0; a < 2; ++a)
#pragma unroll
            for (int b = 0; b < 2; ++b)
#pragma unroll
                for (int m = 0; m < 4; ++m)
#pragma unroll
                    for (int n = 0; n < 2; ++n) acc[a][b][m][n] = (f32x4){0.f, 0.f, 0.f, 0.f};
        cur = nxt; cA = nA; cB = nB; ++ui;
        if constexpr (ALIGN_EPI) { if (wr == 1) PG8_BAR; }
    }
    PG8_WAIT_V(0);
    if constexpr (!ALIGN_EPI) { if (wr == 0) PG8_BAR; }
    PG8_BAR;
    if constexpr (Epi::AFTER_DRAIN) { E.fused(acc, cur, wr, wc, fr, fq, lds, wid, lane); S.done(cur); }
#undef PG8_SA
#undef PG8_SB
#undef PG8_STAGE
#undef PG8_LDA
#undef PG8_LDB
#undef PG8_MMA
#undef PG8_WAIT_V
#undef PG8_WAIT_L
#undef PG8_BAR
#undef PG8_SCHED
}
}
namespace fox {
constexpr int D = 128, NW = 8, QBLK = 32, KVBLK = 64, QB = NW * QBLK;
constexpr int SHM_V = KVBLK * D * 2, SHM_K = KVBLK * D * 2;
constexpr int LDS_WS = 2 * SHM_V + 2 * SHM_K, LDS_BIAS = LDS_WS + NW * 64 * 4, LDS_BYTES = LDS_BIAS + 8192 * 4;
constexpr float SCALE = 0.08838834764831845f, THR = 8.f;
typedef unsigned short bf16;
typedef short bf16x8 __attribute__((ext_vector_type(8)));
typedef short s16x4 __attribute__((ext_vector_type(4)));
typedef float f32x16 __attribute__((ext_vector_type(16)));
typedef float f32x4 __attribute__((ext_vector_type(4)));
typedef unsigned u32x4 __attribute__((ext_vector_type(4)));
#define KSWZ(row, colB) ((row) * 256 + ((colB) ^ (((row) & 7) << 4)))
#define SBAR() __builtin_amdgcn_sched_barrier(0)
__device__ __forceinline__ int v_st(int k, int c) { const int kk = (k & ~0xC) | ((k & 4) << 1) | ((k & 8) >> 1); return ((kk >> 3) * 4 + (c >> 5)) * 512 + ((kk & 7) * 32 + (c & 31)) * 2; }
__device__ __forceinline__ int v_rd_base(int lane) { return ((lane & 3) << 3) | (((lane >> 2) & 3) << 6) | (((lane >> 4) & 1) << 5) | (((lane >> 5) & 1) << 8); }
constexpr int v_rd_off(int d0, int ks, int half) { return d0 * 512 + ks * 4096 + half * 2048; }
__device__ __forceinline__ int crow(int r, int hi) { return (r & 3) + 8 * (r >> 2) + 4 * hi; }
__device__ __forceinline__ unsigned cvtpk(float lo, float hi) { unsigned r; asm volatile("v_cvt_pk_bf16_f32 %0, %1, %2" : "=v"(r) : "v"(lo), "v"(hi)); return r; }
__device__ __forceinline__ bf16x8 load8(const bf16* p) { return *reinterpret_cast<const bf16x8*>(p); }
__device__ __forceinline__ void mask_tile(f32x16& p0, f32x16& p1, int dq) {
    const float NEG = -__builtin_inff();
#pragma unroll
    for (int r = 0; r < 16; ++r) { const int c = (r & 3) + 8 * (r >> 2);
        if (dq - c < 0) p0[r] = NEG;
        if (dq - c - 32 < 0) p1[r] = NEG; }
}
__device__ __forceinline__ void partialSM(f32x16& p0, f32x16& p1, float& m_reg, float& mn, float& alpha) {
    float pmax = p0[0];
#pragma unroll
    for (int r = 1; r < 16; ++r) pmax = fmaxf(pmax, p0[r]);
#pragma unroll
    for (int r = 0; r < 16; ++r) pmax = fmaxf(pmax, p1[r]);
    { auto rr = __builtin_amdgcn_permlane32_swap(__float_as_uint(pmax), __float_as_uint(pmax), false, false);
      pmax = fmaxf(__uint_as_float(rr[0]), __uint_as_float(rr[1])); }
    constexpr float C2 = 1.4426950408889634f * SCALE;
    if (__builtin_expect(__all((pmax - m_reg) * SCALE <= THR), 1)) { mn = m_reg; alpha = 1.f; }
    else { mn = fmaxf(m_reg, pmax); alpha = __builtin_amdgcn_exp2f((m_reg - mn) * C2); m_reg = mn; }
    const float mnL = -mn * C2;
#pragma unroll
    for (int r = 0; r < 16; ++r) p0[r] = fmaf(p0[r], C2, mnL);
#pragma unroll
    for (int r = 0; r < 16; ++r) p1[r] = fmaf(p1[r], C2, mnL);
#pragma unroll
    for (int r = 0; r < 16; ++r) p0[r] = __builtin_amdgcn_exp2f(p0[r]);
}
__device__ __forceinline__ void finishSM(f32x16& p0, f32x16& p1, float alpha, float& l_reg, bf16x8& pa0, bf16x8& pa1, bf16x8& pa2, bf16x8& pa3) {
#pragma unroll
    for (int r = 0; r < 16; ++r) p1[r] = __builtin_amdgcn_exp2f(p1[r]);
    float ps = 0;
#pragma unroll
    for (int r = 0; r < 16; ++r) ps += p0[r];
#pragma unroll
    for (int r = 0; r < 16; ++r) ps += p1[r];
    { auto rr = __builtin_amdgcn_permlane32_swap(__float_as_uint(ps), __float_as_uint(ps), false, false);
      ps = __uint_as_float(rr[0]) + __uint_as_float(rr[1]); }
    l_reg = l_reg * alpha + ps;
#define PK4(P, B_, OUT) do { unsigned a0 = cvtpk(P[B_+0], P[B_+1]), a1 = cvtpk(P[B_+2], P[B_+3]);                          \
        unsigned b0 = cvtpk(P[B_+4], P[B_+5]), b1 = cvtpk(P[B_+6], P[B_+7]);                                             \
        auto r0 = __builtin_amdgcn_permlane32_swap(a0, b0, false, false); auto r1 = __builtin_amdgcn_permlane32_swap(a1, b1, false, false); \
        u32x4 w = {r0[0], r1[0], r0[1], r1[1]}; OUT = *reinterpret_cast<bf16x8*>(&w); } while (0)
    PK4(p0, 0, pa0); PK4(p0, 8, pa1); PK4(p1, 0, pa2); PK4(p1, 8, pa3);
#undef PK4
}
template <int KB>
__device__ __forceinline__ void qkt(f32x16& p0, f32x16& p1, const char* K_lds, int r32, int hi, const bf16x8* qr, const float* bl) {
#pragma unroll
    for (int g = 0; g < 4; ++g) { const f32x4 a = *(const f32x4*)(bl + 8 * g), b = *(const f32x4*)(bl + 32 + 8 * g);
        p0[4 * g + 0] = a[0]; p0[4 * g + 1] = a[1]; p0[4 * g + 2] = a[2]; p0[4 * g + 3] = a[3];
        p1[4 * g + 0] = b[0]; p1[4 * g + 1] = b[1]; p1[4 * g + 2] = b[2]; p1[4 * g + 3] = b[3]; }
    const char* kb[4];
#pragma unroll
    for (int dd = 0; dd < 4; ++dd) kb[dd] = K_lds + KB * SHM_K + KSWZ(r32, (dd * 16 + hi * 8) * 2);
#pragma unroll
    for (int d0 = 0; d0 < 8; ++d0) { const char* a = kb[d0 & 3] + (d0 >> 2) * 128;
        bf16x8 b0 = *reinterpret_cast<const bf16x8*>(a);
        bf16x8 b1 = *reinterpret_cast<const bf16x8*>(a + 32 * 256);
        p0 = __builtin_amdgcn_mfma_f32_32x32x16_bf16(b0, qr[d0], p0, 0, 0, 0);
        p1 = __builtin_amdgcn_mfma_f32_32x32x16_bf16(b1, qr[d0], p1, 0, 0, 0); }
}
template <int VB>
__device__ __forceinline__ void pv_tile(f32x16* o, int vb0, bf16x8 pa0, bf16x8 pa1, bf16x8 pa2, bf16x8 pa3) {
#define TRRD(dst, off) asm volatile("ds_read_b64_tr_b16 %0, %1 offset:%2" : "=&v"(dst) : "v"(vb0), "i"(off) : "memory")
#define PV_D0(d0) do { s16x4 l0, l1, l2, l3, h0, h1, h2, h3; constexpr int b_ = VB * SHM_V + v_rd_off(d0, 0, 0); \
        TRRD(l0, b_); TRRD(h0, b_ + 2048); TRRD(l1, b_ + 4096); TRRD(h1, b_ + 6144); TRRD(l2, b_ + 8192); TRRD(h2, b_ + 10240); TRRD(l3, b_ + 12288); TRRD(h3, b_ + 14336); \
        asm volatile("s_waitcnt lgkmcnt(0)" ::: "memory"); SBAR();   \
        o[d0] = __builtin_amdgcn_mfma_f32_32x32x16_bf16(pa0, (bf16x8){l0[0], l0[1], l0[2], l0[3], h0[0], h0[1], h0[2], h0[3]}, o[d0], 0, 0, 0);   \
        o[d0] = __builtin_amdgcn_mfma_f32_32x32x16_bf16(pa1, (bf16x8){l1[0], l1[1], l1[2], l1[3], h1[0], h1[1], h1[2], h1[3]}, o[d0], 0, 0, 0);   \
        o[d0] = __builtin_amdgcn_mfma_f32_32x32x16_bf16(pa2, (bf16x8){l2[0], l2[1], l2[2], l2[3], h2[0], h2[1], h2[2], h2[3]}, o[d0], 0, 0, 0);   \
        o[d0] = __builtin_amdgcn_mfma_f32_32x32x16_bf16(pa3, (bf16x8){l3[0], l3[1], l3[2], l3[3], h3[0], h3[1], h3[2], h3[3]}, o[d0], 0, 0, 0); } while (0)
    PV_D0(0); PV_D0(1); PV_D0(2); PV_D0(3);
#undef PV_D0
#undef TRRD
}
struct BlockRef { const bf16* Q; const bf16* K; const bf16* V; bf16* O; int P0; };
struct Seam { bf16x8 qr[8]; bf16x8 st_v0, st_v1, st_k0, st_k1; };
#define VMW() asm volatile("s_waitcnt vmcnt(0)" ::: "memory")
#define VMWN(n) asm volatile("s_waitcnt vmcnt(%0)" :: "i"(n) : "memory")
#define LDG8(base, off) (*(const bf16x8*)((const char*)(base) + (off)))
#define SLOAD_H(Kp, Vp, k0) do { const bf16* vb_ = (Vp) + (size_t)(k0) * PIN; const bf16* kb_ = (Kp) + (size_t)(k0) * PIN;                        \
        S.st_v0 = LDG8(vb_, voff); S.st_v1 = LDG8(vb_ + (size_t)32 * PIN, voff); S.st_k0 = LDG8(kb_, voff); S.st_k1 = LDG8(kb_ + (size_t)32 * PIN, voff); } while (0)
#define SWRITE_HK(bf) do { *(bf16x8*)(K_lds + (bf) * SHM_K + kws) = S.st_k0; *(bf16x8*)(K_lds + (bf) * SHM_K + kws + 32 * 256) = S.st_k1; } while (0)
#define SWRITE_HV(bf) do { *(bf16x8*)(V_lds + (bf) * SHM_V + vst0) = S.st_v0; *(bf16x8*)(V_lds + (bf) * SHM_V + vst1) = S.st_v1; } while (0)
#define SWRITE_H(bf) do { SWRITE_HV(bf); SWRITE_HK(bf); } while (0)
template <int PIN>
__device__ __forceinline__ void fox_prime(const BlockRef& cur, char* lds, Seam& S) {
    const int tid = threadIdx.x, wid = __builtin_amdgcn_readfirstlane(tid >> 6), lane = tid & 63, r32 = lane & 31, hi = lane >> 5;
    const int sr = tid >> 4, sc = (tid & 15) * 8, kws = KSWZ(sr, sc * 2); char* K_lds = lds + 2 * SHM_V;
    const unsigned voff = (unsigned)(sr * PIN + sc) * 2u, qoff = (unsigned)(r32 * PIN + hi * 8) * 2u;
    { const bf16* qb_ = cur.Q + (size_t)(wid * QBLK) * PIN;
#pragma unroll
      for (int d0 = 0; d0 < 8; ++d0) S.qr[d0] = LDG8(qb_ + d0 * 16, qoff); }
    SLOAD_H(cur.K, cur.V, 0); VMW(); SWRITE_HK(0);
    __syncthreads();
}
template <int PIN, int POUT>
__device__ __forceinline__ void fox_block(const BlockRef& cur, const BlockRef& nxt, char* lds, Seam& S) {
    const int tid = threadIdx.x, wid = __builtin_amdgcn_readfirstlane(tid >> 6), lane = tid & 63, r32 = lane & 31, hi = lane >> 5;
    const int NT = (cur.P0 + QB - 1) / KVBLK + 1;
    const int qlo = cur.P0 + wid * QBLK, qm = qlo + r32 - 4 * hi;
    char* V_lds = lds; char* K_lds = lds + 2 * SHM_V;
    float* ws = (float*)(lds + LDS_WS) + wid * 64; float* li_l = ws, * al_l = ws + 32;
    const float* bias = (const float*)(lds + LDS_BIAS) + 4 * hi;
    float m_reg = -1e30f, l_reg = 0; f32x16 o[4] = {};
    const int sr = tid >> 4, sc = (tid & 15) * 8, vst0 = v_st(sr, sc), vst1 = v_st(32 + sr, sc), kws = KSWZ(sr, sc * 2);
    const unsigned voff = (unsigned)(sr * PIN + sc) * 2u, qoff = (unsigned)(r32 * PIN + hi * 8) * 2u;
    const int vb0 = (int)(uintptr_t)V_lds + v_rd_base(lane);
    const bf16* Kh = cur.K; const bf16* Vh = cur.V;
#define RESC(a) do { if (__any((a) < 1.f)) { if (hi == 0) al_l[r32] = (a); asm volatile("s_waitcnt lgkmcnt(0)" ::: "memory");              \
                     for (int d_ = 0; d_ < 4; ++d_) for (int r = 0; r < 16; ++r) o[d_][r] *= al_l[crow(r, hi)]; } } while (0)
#define KBASE(t) ((t) * KVBLK)
#define MASKT(P0_, P1_, t) do { const int kb_ = KBASE(t); if (kb_ + KVBLK - 1 > qlo) mask_tile(P0_, P1_, qm - kb_); } while (0)
    constexpr int NQL = 8;
#define SEAM_K0() do { VMWN(NQL); SWRITE_HK(0); SBAR(); } while (0)
    f32x16 pA0, pA1, pB0, pB1; float mnA, mnB, alA, alB; bf16x8 pa0, pa1, pa2, pa3;
    SWRITE_HV(0); SBAR();
    if (NT > 1) SLOAD_H(Kh, Vh, KBASE(1));
    SBAR(); qkt<0>(pA0, pA1, K_lds, r32, hi, S.qr, bias + KBASE(0));
    MASKT(pA0, pA1, 0); partialSM(pA0, pA1, m_reg, mnA, alA);
    if (NT > 1) { VMW(); SWRITE_H(1); }
    __syncthreads();
#define HALF_STEP(PX0, PX1, mnX, alX, PY0, PY1, alY, t, KB, VB, SB) do {                                                      \
        SBAR(); qkt<KB>(PX0, PX1, K_lds, r32, hi, S.qr, bias + KBASE(t));                                                     \
        finishSM(PY0, PY1, alY, l_reg, pa0, pa1, pa2, pa3); SBAR();                                                           \
        if ((t) + 1 < NT) { SLOAD_H(Kh, Vh, KBASE((t) + 1)); SBAR(); }                                                        \
        pv_tile<VB>(o, vb0, pa0, pa1, pa2, pa3); MASKT(PX0, PX1, (t)); partialSM(PX0, PX1, m_reg, mnX, alX);                  \
        __syncthreads();                                                                                                      \
        if ((t) + 1 < NT) { VMW(); SWRITE_H(SB); }                                                                            \
        RESC(alX); __syncthreads(); } while (0)
    for (int t = 1; t + 1 < NT; t += 2) {
        HALF_STEP(pB0, pB1, mnB, alB, pA0, pA1, alA, t, 1, 0, 0);
        HALF_STEP(pA0, pA1, mnA, alA, pB0, pB1, alB, t + 1, 0, 1, 1);
    }
    const bool even = (NT & 1) == 0;
    if (even) { SBAR(); qkt<1>(pB0, pB1, K_lds, r32, hi, S.qr, bias + KBASE(NT - 1)); SBAR(); }
    SLOAD_H(nxt.K, nxt.V, 0); SBAR();
    { const bf16* qb_ = nxt.Q + (size_t)(wid * QBLK) * PIN;
#pragma unroll
      for (int d0 = 0; d0 < 8; ++d0) S.qr[d0] = LDG8(qb_ + d0 * 16, qoff); }
    SBAR();
    finishSM(pA0, pA1, alA, l_reg, pa0, pa1, pa2, pa3); SBAR();
    pv_tile<0>(o, vb0, pa0, pa1, pa2, pa3);
    if (even) { MASKT(pB0, pB1, NT - 1); partialSM(pB0, pB1, m_reg, mnB, alB); __syncthreads(); RESC(alB);
        finishSM(pB0, pB1, alB, l_reg, pa0, pa1, pa2, pa3); SBAR(); pv_tile<1>(o, vb0, pa0, pa1, pa2, pa3); }
    SBAR(); SEAM_K0();
    if (hi == 0) li_l[r32] = l_reg; asm volatile("s_waitcnt lgkmcnt(0)" ::: "memory");
    float rli[16];
#pragma unroll
    for (int r = 0; r < 16; ++r) rli[r] = __builtin_amdgcn_rcpf(li_l[crow(r, hi)]);
    bf16* Ow = cur.O + (size_t)(wid * QBLK) * POUT;
#pragma unroll
    for (int r = 0; r < 16; ++r) { const int orow = crow(r, hi);
#pragma unroll
        for (int d0 = 0; d0 < 4; ++d0) { const float v = o[d0][r] * rli[r];
            const float vn = __shfl_xor(v, 1);
            if ((r32 & 1) == 0) *(unsigned*)(Ow + (size_t)orow * POUT + d0 * 32 + r32) = cvtpk(v, vn); } }
    __syncthreads();
#undef RESC
#undef KBASE
#undef MASKT
#undef SEAM_K0
#undef HALF_STEP
}
#undef LDG8
#undef VMW
#undef VMWN
#undef SLOAD_H
#undef SWRITE_HK
#undef SWRITE_HV
#undef SWRITE_H
template <int PIN, int POUT>
__device__ __forceinline__ void fox_phase(char* lds, const bf16* Zq, const bf16* Zk, const bf16* Zv, const float* NCB, bf16* O, int G, int w) {
    constexpr int SEQ = 8192, NH = 32, NQB = SEQ / QB, NX = NQB / 2, TOTAL = 2 * NH * NX;
    int L = w; if (L >= TOTAL) return;
    const int tid = threadIdx.x;
    int pass = 0;
#define DECODE(L_, bh_, x_) do { bh_ = ((L_) >> 7) * 8 + ((L_) & 7); x_ = ((L_) >> 3) & 15; } while (0)
#define MKREF(r_, bh_, qb_) do { const int b_ = (bh_) >> 5, h_ = (bh_) & 31; const size_t row0_ = (size_t)b_ * SEQ; \
        r_.Q = Zq + (row0_ + (size_t)(qb_) * QB) * PIN + h_ * D; r_.K = Zk + row0_ * PIN + h_ * D; r_.V = Zv + row0_ * PIN + h_ * D; \
        r_.O = O + (row0_ + (size_t)(qb_) * QB) * POUT + h_ * D; r_.P0 = (qb_) * QB; } while (0)
    int bh, x; DECODE(L, bh, x);
    BlockRef cur; MKREF(cur, bh, x);
    Seam S;
    { const f32x4* src = (const f32x4*)(NCB + (size_t)bh * SEQ); f32x4* dst = (f32x4*)(lds + LDS_BIAS); const int n4 = (NQB - x) * QB / 4;
      for (int i = tid; i < n4; i += NW * 64) dst[i] = src[i]; }
    fox_prime<PIN>(cur, lds, S);
    for (;;) {
        const bool more_pass = pass == 0, more_item = L + G < TOTAL, last = !more_pass && !more_item;
        int bhn = bh, xn = x, passn = pass + 1, Ln = L;
        if (!more_pass) { passn = 0; Ln = more_item ? L + G : L; DECODE(Ln, bhn, xn); }
        BlockRef nxt; if (last) nxt = cur; else MKREF(nxt, bhn, passn ? NQB - 1 - xn : xn);
        fox_block<PIN, POUT>(cur, nxt, lds, S);
        if (last) break;
        if (!more_pass) { const f32x4* src = (const f32x4*)(NCB + (size_t)bhn * SEQ); f32x4* dst = (f32x4*)(lds + LDS_BIAS); const int n4 = (NQB - xn) * QB / 4;
            for (int i = tid; i < n4; i += NW * 64) dst[i] = src[i];
            __syncthreads(); }
        cur = nxt; bh = bhn; x = xn; pass = passn; L = Ln;
    }
#undef DECODE
#undef MKREF
}
#undef KSWZ
#undef SBAR
}
constexpr int NWAVES = 8;
constexpr int BATCH = 2, SEQ = 8192, DM = 4096, NH = 32, HD = 128, DFF = 11008, PLE = 256;
constexpr int M = BATCH * SEQ;
constexpr int INC = 8 * DM + NH;
constexpr int ZC = 8 * DM;
constexpr int ZT = ZC / 256;
constexpr int Z_CB = 0, Z_CC = DM, Z_CV = 2 * DM, Z_Q = 3 * DM, Z_K = 4 * DM, Z_V = 5 * DM, Z_GA = 6 * DM, Z_GB = 7 * DM;
constexpr int NSLOT = 64;
constexpr float EPS = 1e-6f;
constexpr int N_PHASES = 15;

constexpr size_t MiB = 1u << 20;
constexpr size_t WS_CTL = 0, CTL_ZERO_BYTES = 1 * MiB;
constexpr size_t WS_FLT = 1 * MiB;
constexpr size_t WS_NCB = 3 * MiB;
constexpr size_t WS_SSP1 = 5 * MiB;
constexpr size_t WS_WA = 9 * MiB, WS_WB = 41 * MiB, WS_WOUT = 73 * MiB, WS_WPG = 105 * MiB, WS_WPLE = 137 * MiB;
constexpr size_t WS_PB = 139 * MiB;
constexpr size_t WS_WUP = 147 * MiB;
constexpr size_t WS_WDN = 319 * MiB;
constexpr size_t WS_WIN = 405 * MiB;
constexpr size_t WS_U = WS_WIN, WS_O = WS_WIN + 128 * MiB;
constexpr size_t WS_W1 = WS_U;
constexpr size_t WS_E = WS_O;
constexpr size_t WS_H = 663 * MiB;
constexpr size_t WS_MM = WS_H;
constexpr size_t WS_Z = 791 * MiB;
constexpr size_t WS_UP = WS_Z, WS_ACT = WS_Z + 688 * MiB;
constexpr size_t WS_W2 = WS_Z;
constexpr size_t WS_GE = WS_Z + 128 * MiB;
constexpr size_t WS_SSP2 = WS_Z + 1032 * MiB, WS_SSP3 = WS_SSP2 + 4 * MiB;
constexpr size_t WS_END = WS_SSP3 + 4 * MiB;
static_assert(WS_WPLE + (size_t)DM * PLE * 2 <= WS_PB && WS_PB + (size_t)M * PLE * 2 <= WS_WUP && WS_WUP + (size_t)2 * DFF * DM * 2 <= WS_WDN && WS_WDN + (size_t)DM * DFF * 2 <= WS_WIN, "ws map 1");
static_assert(WS_WIN + (size_t)(ZC + 256) * DM * 2 <= WS_H && WS_H + (size_t)M * DM * 2 <= WS_Z && WS_Z + (size_t)M * ZC * 2 <= WS_END && WS_ACT + (size_t)M * DFF * 2 <= WS_END && WS_UP + (size_t)M * 2 * DFF * 2 <= WS_ACT, "ws map 2");
constexpr int CW_TMO = 0, CW_CODE = 1;
constexpr int CW_BAR = 4096;

constexpr int RING_OFF = 0, RING_BYTES = 131072;
constexpr int LDSCTL_OFF = RING_BYTES, MISC_OFF = LDSCTL_OFF + 320;
constexpr int LDS_BYTES = 147456;
static_assert(MISC_OFF + 128 <= LDS_BYTES && fox::LDS_BYTES <= RING_BYTES, "LDS map");

#define GAS __attribute__((address_space(1)))
#define LAS __attribute__((address_space(3)))
typedef unsigned short bf16;
typedef unsigned v4u __attribute__((ext_vector_type(4)));
typedef unsigned v2u __attribute__((ext_vector_type(2)));
typedef float f32x4 __attribute__((ext_vector_type(4)));
typedef GAS unsigned gu32;
#define RLX_AGENT __ATOMIC_RELAXED, __HIP_MEMORY_SCOPE_AGENT
#define LDS_WAIT() asm volatile("s_waitcnt lgkmcnt(0)" ::: "memory")
#define VM_WAIT() asm volatile("s_waitcnt vmcnt(0)" ::: "memory")
__device__ __forceinline__ unsigned f2bf(float f) { unsigned u = __builtin_bit_cast(unsigned, f); return (u + 0x7fffu + ((u >> 16) & 1u)) >> 16; }
__device__ __forceinline__ unsigned pk2(float lo, float hi) { return f2bf(lo) | (f2bf(hi) << 16); }
__device__ __forceinline__ float bflo(unsigned w) { return __uint_as_float(w << 16); }
__device__ __forceinline__ float bfhi(unsigned w) { return __uint_as_float(w & 0xffff0000u); }
#define XB_TMO      128
#define XB_XCNT(j)  (256  + 64 * (j))
#define XB_XSUB(j)  (1280 + 64 * (j))
#define XB_XGEN(j)  (2304 + 64 * (j))
#define XB_TOP      3328
#define XB_TOPGEN   3392
#define XCD_BAR_WORDS 3456
#define XB_SPIN_CAP (1u << 18)

__device__ __forceinline__ unsigned xb_ld(unsigned* p)              { return __hip_atomic_load(p, __ATOMIC_RELAXED, __HIP_MEMORY_SCOPE_AGENT); }
__device__ __forceinline__ unsigned xb_add(unsigned* p, unsigned v) { return __hip_atomic_fetch_add(p, v, __ATOMIC_RELAXED, __HIP_MEMORY_SCOPE_AGENT); }
__device__ __forceinline__ unsigned xb_xcc_id() { return (unsigned)__builtin_amdgcn_s_getreg((3 << 11) | 20) & 0xFu; }
#define XB_SPIN(cond, bar) do { unsigned _sp = 0; while (cond) { __builtin_amdgcn_s_sleep(1); \
    if ((++_sp & 255u) == 0u) { if (xb_ld(&(bar)[XB_TMO])) break; if (_sp > XB_SPIN_CAP) { atomicAdd(&(bar)[XB_TMO], 1u); break; } } } } while (0)

struct XcdBarrier {
    unsigned* bar; unsigned x;
    volatile LAS unsigned* st;
};

__device__ __forceinline__ XcdBarrier xcd_barrier_post(unsigned* bar, volatile LAS unsigned* st) {
    XcdBarrier b; b.bar = bar; b.x = xb_xcc_id(); b.st = st;
    if (threadIdx.x == 0) (void)xb_add(&bar[XB_XCNT(b.x)], 1u);
    return b;
}
__device__ __forceinline__ void xcd_barrier_complete(unsigned* bar, unsigned x, unsigned& nloc, unsigned& nx) {
    const unsigned G = gridDim.x * gridDim.y * gridDim.z;
    unsigned sum, cnt, mine, sp = 0u;
    for (;;) {
        sum = 0u; cnt = 0u; mine = 0u;
#pragma unroll
        for (unsigned j = 0; j < 16; ++j) { const unsigned c = xb_ld(&bar[XB_XCNT(j)]); sum += c; cnt += (c > 0u) ? 1u : 0u; mine = (j == x) ? c : mine; }
        if (sum == G) break;
        __builtin_amdgcn_s_sleep(1);
        if ((++sp & 255u) == 0u) { if (xb_ld(&bar[XB_TMO])) break; if (sp > XB_SPIN_CAP) { atomicAdd(&bar[XB_TMO], 1u); break; } }
    }
    nloc = mine > 0u ? mine : 1u; nx = cnt > 0u ? cnt : 1u;
}

__device__ __forceinline__ void xcd_barrier(const XcdBarrier& b) {
    asm volatile("s_waitcnt vmcnt(0)" ::: "memory");
    __syncthreads();
    if (threadIdx.x == 0) {
        unsigned* bar = b.bar;
        __builtin_amdgcn_s_waitcnt(0);
        unsigned nloc = b.st[0], nx = b.st[1];
        if (nloc == 0u) { xcd_barrier_complete(bar, b.x, nloc, nx); b.st[0] = nloc; b.st[1] = nx; }
        const unsigned old = xb_add(&bar[XB_XSUB(b.x)], 1u);
        const unsigned gen = old / nloc;
        if (old + 1u == (gen + 1u) * nloc) {
            __builtin_amdgcn_fence(__ATOMIC_RELEASE, "agent");
            asm volatile("s_waitcnt vmcnt(0)" ::: "memory");
            const unsigned og = xb_add(&bar[XB_TOP], 1u);
            const unsigned tg = og / nx;
            if (og + 1u == (tg + 1u) * nx) xb_add(&bar[XB_TOPGEN], 1u);
            else XB_SPIN(xb_ld(&bar[XB_TOPGEN]) == tg, bar);
            __builtin_amdgcn_fence(__ATOMIC_ACQUIRE, "agent");
            xb_add(&bar[XB_XGEN(b.x)], 1u);
            asm volatile("s_waitcnt vmcnt(0)" ::: "memory");
        } else {
            XB_SPIN(xb_ld(&bar[XB_XGEN(b.x)]) == gen, bar);
            __builtin_amdgcn_fence(__ATOMIC_ACQUIRE, "agent");
            asm volatile("s_waitcnt vmcnt(0)" ::: "memory");
        }
    }
    __syncthreads();
}

struct Frame {
    LAS unsigned char* lds;
    volatile LAS unsigned* MISC;
    gu32* ctl;
    int tid, lane, wave;
    int vcu, G;
};
__device__ __forceinline__ float wave_sum(float v) {
#pragma unroll
    for (int o = 1; o < 64; o <<= 1) v += __shfl_xor(v, o);
    return v;
}
__device__ __forceinline__ void p0_transpose_item(const float* W, int K, int ldw, int col_off, int nblk, bf16* WT, int row_off, LAS float* scr, int item, int lane, const float* gain) {
    const int kb = item / nblk, nb = item % nblk, k0 = 64 * kb, n0 = 32 * nb;
#pragma unroll 8
    for (int i = 0; i < 32; ++i) { const int kk = 2 * i + (lane >> 5); const float gk = gain ? gain[k0 + kk] : 1.f; scr[kk * 33 + (lane & 31)] = W[(size_t)(k0 + kk) * ldw + col_off + n0 + (lane & 31)] * gk; }
    LDS_WAIT(); asm volatile("" ::: "memory");
    const int c = lane & 7;
#pragma unroll
    for (int j = 0; j < 4; ++j) { const int n = (lane >> 3) + 8 * j; const LAS float* s = scr + (8 * c) * 33 + n;
        v4u o; o.x = pk2(s[0 * 33], s[1 * 33]); o.y = pk2(s[2 * 33], s[3 * 33]); o.z = pk2(s[4 * 33], s[5 * 33]); o.w = pk2(s[6 * 33], s[7 * 33]);
        *(GAS v4u*)(WT + (size_t)(row_off + n0 + n) * K + k0 + 8 * c) = o; }
    LDS_WAIT(); asm volatile("" ::: "memory");
}
__device__ __forceinline__ void rms_row_to_bf16(int lane, const float* xrow, bf16* orow) {
    const GAS f32x4* xr = (const GAS f32x4*)xrow + lane;
    f32x4 v[16]; float s = 0.f;
#pragma unroll
    for (int j = 0; j < 16; ++j) { v[j] = xr[64 * j]; s += (v[j].x * v[j].x + v[j].y * v[j].y) + (v[j].z * v[j].z + v[j].w * v[j].w); }
    const float inv = 1.f / sqrtf(wave_sum(s) * (1.f / DM) + EPS);
    GAS v2u* o8 = (GAS v2u*)orow + lane;
#pragma unroll
    for (int j = 0; j < 16; ++j) { v2u w; w.x = pk2(v[j].x * inv, v[j].y * inv); w.y = pk2(v[j].z * inv, v[j].w * inv); o8[64 * j] = w; }
}
struct In { const float *x, *p, *g_mix_pre, *w_in, *fbias, *conv_w, *w_a, *w_b, *w_out, *g_mix_post, *g_ffn_pre, *w_up, *ffn_cw, *ffn_cb, *w_down, *g_ffn_post, *w_ple, *g_ple_gate, *w_pg, *g_ple_post; };

__device__ __forceinline__ void p0_prologue(Frame& F, const In& I, unsigned char* ws) {
    LAS float* scr = (LAS float*)(F.lds + RING_OFF + F.wave * 16384);
    const int gw = F.vcu * NWAVES + F.wave, NGW = F.G * NWAVES;
    bf16* WIN = (bf16*)(ws + WS_WIN);
    constexpr int KB4 = DM / 64;
    constexpr int I_IN1 = KB4 * (6 * DM / 32), I_INF = KB4 * 1, I_IN2 = KB4 * (2 * DM / 32);
    constexpr int I_SQ = KB4 * (DM / 32);
    constexpr int I_UP = KB4 * (2 * DFF / 32), I_DN = (DFF / 64) * (DM / 32), I_PLE = (PLE / 64) * (DM / 32);
    constexpr int NITEMS = I_IN1 + I_INF + I_IN2 + 4 * I_SQ + I_UP + I_DN + I_PLE;
    for (int it = gw; it < NITEMS; it += NGW) {
        int r = it;
        if (r < I_IN1) { p0_transpose_item(I.w_in, DM, INC, 0, 6 * DM / 32, WIN, 0, scr, r, F.lane, I.g_mix_pre); continue; } r -= I_IN1;
        if (r < I_INF) { p0_transpose_item(I.w_in, DM, INC, 6 * DM, 1, WIN, ZC, scr, r, F.lane, I.g_mix_pre); continue; } r -= I_INF;
        if (r < I_IN2) { p0_transpose_item(I.w_in, DM, INC, 6 * DM + NH, 2 * DM / 32, WIN, 6 * DM, scr, r, F.lane, I.g_mix_pre); continue; } r -= I_IN2;
        if (r < I_SQ) { p0_transpose_item(I.w_a, DM, DM, 0, DM / 32, (bf16*)(ws + WS_WA), 0, scr, r, F.lane, nullptr); continue; } r -= I_SQ;
        if (r < I_SQ) { p0_transpose_item(I.w_b, DM, DM, 0, DM / 32, (bf16*)(ws + WS_WB), 0, scr, r, F.lane, nullptr); continue; } r -= I_SQ;
        if (r < I_SQ) { p0_transpose_item(I.w_out, DM, DM, 0, DM / 32, (bf16*)(ws + WS_WOUT), 0, scr, r, F.lane, nullptr); continue; } r -= I_SQ;
        if (r < I_SQ) { p0_transpose_item(I.w_pg, DM, DM, 0, DM / 32, (bf16*)(ws + WS_WPG), 0, scr, r, F.lane, I.g_ple_gate); continue; } r -= I_SQ;
        if (r < I_UP) { p0_transpose_item(I.w_up, DM, 2 * DFF, 0, 2 * DFF / 32, (bf16*)(ws + WS_WUP), 0, scr, r, F.lane, I.g_ffn_pre); continue; } r -= I_UP;
        if (r < I_DN) { p0_transpose_item(I.w_down, DFF, DM, 0, DM / 32, (bf16*)(ws + WS_WDN), 0, scr, r, F.lane, nullptr); continue; } r -= I_DN;
        p0_transpose_item(I.w_ple, PLE, DM, 0, DM / 32, (bf16*)(ws + WS_WPLE), 0, scr, r, F.lane, nullptr);
    }
    bf16* H = (bf16*)(ws + WS_H);
    for (int m = gw; m < M; m += NGW) rms_row_to_bf16(F.lane, I.x + (size_t)m * DM, H + (size_t)m * DM);
    { const GAS f32x4* src = (const GAS f32x4*)I.p; GAS v2u* dst = (GAS v2u*)(ws + WS_PB); const size_t n4 = (size_t)M * PLE / 4;
      for (size_t i = (size_t)gw * 64 + F.lane; i < n4; i += (size_t)NGW * 64) { const f32x4 v = src[i]; v2u w; w.x = pk2(v.x, v.y); w.y = pk2(v.z, v.w); dst[i] = w; } }
}

__device__ __forceinline__ float log_sigmoid_f(float x) { return fminf(x, 0.f) - log1pf(expf(-fabsf(x))); }
__device__ __forceinline__ void p2_conv_scan(Frame& F, const In& I, unsigned char* ws) {
    const bf16* Z = (const bf16*)(ws + WS_Z); bf16* U = (bf16*)(ws + WS_U);
    const int gw = F.vcu * NWAVES + F.wave;
    if (gw < BATCH * NH) {
        const int b = gw >> 5, h = gw & 31; const float fb = I.fbias[h];
        const GAS f32x4* src = (const GAS f32x4*)((const float*)(ws + WS_FLT) + (size_t)h * M + (size_t)b * SEQ) + F.lane;
        GAS f32x4* dst = (GAS f32x4*)((float*)(ws + WS_NCB) + (size_t)gw * SEQ) + F.lane;
        float carry = 0.f; const float k = -11.313708498984761f;
        for (int i = 0; i < SEQ / 256; ++i) {
            const f32x4 v = src[64 * i];
            const float s0 = log_sigmoid_f(v.x + fb), s1 = s0 + log_sigmoid_f(v.y + fb), s2 = s1 + log_sigmoid_f(v.z + fb), s3 = s2 + log_sigmoid_f(v.w + fb);
            float inc = s3;
#pragma unroll
            for (int o = 1; o < 64; o <<= 1) { const float t = __shfl_up(inc, o); if (F.lane >= o) inc += t; }
            const float base = carry + (inc - s3);
            f32x4 c; c.x = (base + s0) * k; c.y = (base + s1) * k; c.z = (base + s2) * k; c.w = (base + s3) * k;
            dst[64 * i] = c;
            carry += __shfl(inc, 63);
        }
    }
    const int c0 = (F.wave * 64 + F.lane) * 8;
    f32x4 w0a, w0b, w1a, w1b, w2a, w2b;
    { const float* cw = I.conv_w; w0a = *(const f32x4*)(cw + c0); w0b = *(const f32x4*)(cw + c0 + 4); w1a = *(const f32x4*)(cw + DM + c0); w1b = *(const f32x4*)(cw + DM + c0 + 4);
      w2a = *(const f32x4*)(cw + 2 * DM + c0); w2b = *(const f32x4*)(cw + 2 * DM + c0 + 4); }
    constexpr int RUN = 32;
    for (int run = F.vcu; run < M / RUN; run += F.G) {
        const int r0 = run * RUN; const int t0 = r0 & (SEQ - 1);
        f32x4 p2a = {0.f, 0.f, 0.f, 0.f}, p2b = p2a, p1a = p2a, p1b = p2a;
#define LOADPROD(row, A, B) do { const v4u cc = *(const GAS v4u*)(Z + (size_t)(row) * ZC + Z_CC + c0), cv = *(const GAS v4u*)(Z + (size_t)(row) * ZC + Z_CV + c0); \
        A.x = bflo(cc.x) * bflo(cv.x); A.y = bfhi(cc.x) * bfhi(cv.x); A.z = bflo(cc.y) * bflo(cv.y); A.w = bfhi(cc.y) * bfhi(cv.y); \
        B.x = bflo(cc.z) * bflo(cv.z); B.y = bfhi(cc.z) * bfhi(cv.z); B.z = bflo(cc.w) * bflo(cv.w); B.w = bfhi(cc.w) * bfhi(cv.w); } while (0)
        if (t0 >= 2) { LOADPROD(r0 - 2, p2a, p2b); LOADPROD(r0 - 1, p1a, p1b); }
        for (int r = r0; r < r0 + RUN; r += 4) {
            v4u cc4[4], cv4[4], cb4[4];
#pragma unroll
            for (int q = 0; q < 4; ++q) { cc4[q] = *(const GAS v4u*)(Z + (size_t)(r + q) * ZC + Z_CC + c0); cv4[q] = *(const GAS v4u*)(Z + (size_t)(r + q) * ZC + Z_CV + c0); cb4[q] = *(const GAS v4u*)(Z + (size_t)(r + q) * ZC + Z_CB + c0); }
#pragma unroll
            for (int q = 0; q < 4; ++q) {
                const v4u cc = cc4[q], cv = cv4[q], cb = cb4[q]; f32x4 pa, pb;
                pa.x = bflo(cc.x) * bflo(cv.x); pa.y = bfhi(cc.x) * bfhi(cv.x); pa.z = bflo(cc.y) * bflo(cv.y); pa.w = bfhi(cc.y) * bfhi(cv.y);
                pb.x = bflo(cc.z) * bflo(cv.z); pb.y = bfhi(cc.z) * bfhi(cv.z); pb.z = bflo(cc.w) * bflo(cv.w); pb.w = bfhi(cc.w) * bfhi(cv.w);
                const f32x4 ya = w0a * p2a + w1a * p1a + w2a * pa, yb = w0b * p2b + w1b * p1b + w2b * pb;
                v4u o; o.x = pk2(bflo(cb.x) * ya.x, bfhi(cb.x) * ya.y); o.y = pk2(bflo(cb.y) * ya.z, bfhi(cb.y) * ya.w);
                o.z = pk2(bflo(cb.z) * yb.x, bfhi(cb.z) * yb.y); o.w = pk2(bflo(cb.w) * yb.z, bfhi(cb.w) * yb.w);
                *(GAS v4u*)(U + (size_t)(r + q) * DM + c0) = o;
                p2a = p1a; p2b = p1b; p1a = pa; p1b = pb;
            }
        }
#undef LOADPROD
    }
}

struct Term { const bf16* W; const float* SSP; };
typedef int v4i __attribute__((ext_vector_type(4)));
typedef int v2i __attribute__((ext_vector_type(2)));
#define MKRSRC(p, nbytes) __builtin_amdgcn_make_buffer_rsrc((void*)(p), (short)0, (int)(nbytes), 0x00020000)
template <int NT, bool NEXT>
__device__ __forceinline__ void rowwise_residual(Frame& F, const float* x, const Term Ta, const Term Tb, const Term Tc, bf16* H, float* out) {
    const int gw = F.vcu * NWAVES + F.wave, NGW = F.G * NWAVES;
    const auto rx = MKRSRC(x, (size_t)M * DM * 4), ra = MKRSRC(Ta.W, (size_t)M * DM * 2), rb = MKRSRC(Tb.W, (size_t)M * DM * 2), rc = MKRSRC(Tc.W, (size_t)M * DM * 2);
    const auto rh = MKRSRC(NEXT ? (void*)H : (void*)out, NEXT ? (size_t)M * DM * 2 : (size_t)M * DM * 4);
    const int vo16 = F.lane * 16, vo8 = F.lane * 8;
    for (int m = gw; m < M; m += NGW) {
        const float inv0 = 1.f / sqrtf(wave_sum(Ta.SSP[(size_t)m * NSLOT + F.lane]) * (1.f / DM) + EPS);
        float inv1 = 0.f, inv2 = 0.f;
        if constexpr (NT > 1) inv1 = 1.f / sqrtf(wave_sum(Tb.SSP[(size_t)m * NSLOT + F.lane]) * (1.f / DM) + EPS);
        if constexpr (NT > 2) inv2 = 1.f / sqrtf(wave_sum(Tc.SSP[(size_t)m * NSLOT + F.lane]) * (1.f / DM) + EPS);
        f32x4 v[16]; v2i w0[16], w1[16], w2[16];
        const int so4 = m * (DM * 4), so2 = m * (DM * 2);
#pragma unroll
        for (int j = 0; j < 16; ++j) v[j] = __builtin_bit_cast(f32x4, __builtin_amdgcn_raw_buffer_load_b128(rx, vo16 + 1024 * (j & 3), so4 + 4096 * (j >> 2), 0));
#pragma unroll
        for (int j = 0; j < 16; ++j) { w0[j] = __builtin_bit_cast(v2i, __builtin_amdgcn_raw_buffer_load_b64(ra, vo8 + 512 * (j & 7), so2 + 4096 * (j >> 3), 0));
            if constexpr (NT > 1) w1[j] = __builtin_bit_cast(v2i, __builtin_amdgcn_raw_buffer_load_b64(rb, vo8 + 512 * (j & 7), so2 + 4096 * (j >> 3), 0));
            if constexpr (NT > 2) w2[j] = __builtin_bit_cast(v2i, __builtin_amdgcn_raw_buffer_load_b64(rc, vo8 + 512 * (j & 7), so2 + 4096 * (j >> 3), 0)); }
#pragma unroll
        for (int j = 0; j < 16; ++j) {
            { const v2i w = w0[j]; v[j].x += bflo(w.x) * inv0; v[j].y += bfhi(w.x) * inv0; v[j].z += bflo(w.y) * inv0; v[j].w += bfhi(w.y) * inv0; }
            if constexpr (NT > 1) { const v2i w = w1[j]; v[j].x += bflo(w.x) * inv1; v[j].y += bfhi(w.x) * inv1; v[j].z += bflo(w.y) * inv1; v[j].w += bfhi(w.y) * inv1; }
            if constexpr (NT > 2) { const v2i w = w2[j]; v[j].x += bflo(w.x) * inv2; v[j].y += bfhi(w.x) * inv2; v[j].z += bflo(w.y) * inv2; v[j].w += bfhi(w.y) * inv2; }
        }
        if constexpr (NEXT) {
            float s2 = 0.f;
#pragma unroll
            for (int j = 0; j < 16; ++j) s2 += (v[j].x * v[j].x + v[j].y * v[j].y) + (v[j].z * v[j].z + v[j].w * v[j].w);
            const float invn = 1.f / sqrtf(wave_sum(s2) * (1.f / DM) + EPS);
#pragma unroll
            for (int j = 0; j < 16; ++j) { v2u w; w.x = pk2(v[j].x * invn, v[j].y * invn); w.y = pk2(v[j].z * invn, v[j].w * invn);
                __builtin_amdgcn_raw_buffer_store_b64(w, rh, vo8 + 512 * (j & 7), so2 + 4096 * (j >> 3), 0); }
        } else {
#pragma unroll
            for (int j = 0; j < 16; ++j) __builtin_amdgcn_raw_buffer_store_b128(__builtin_bit_cast(v4u, v[j]), rh, vo16 + 1024 * (j & 3), so4 + 4096 * (j >> 2), 0);
        }
    }
}

__device__ __forceinline__ float gelu_tanh_f(float x) {
    const float u = 0.7978845608028654f * (x + 0.044715f * x * x * x);
    return x * __builtin_amdgcn_rcpf(1.0f + __builtin_amdgcn_exp2f(-2.0f * 1.4426950408889634f * u));
}
__device__ __forceinline__ void p9_conv_gelu(Frame& F, const In& I, unsigned char* ws) {
    const bf16* UP = (const bf16*)(ws + WS_UP); bf16* ACT = (bf16*)(ws + WS_ACT);
    constexpr int NCG = DFF / 8, RUN = 32, NRUN = M / RUN;
    const size_t total = (size_t)NRUN * NCG;
    for (size_t it = (size_t)F.vcu * (NWAVES * 64) + F.tid; it < total; it += (size_t)F.G * (NWAVES * 64)) {
        const int run = (int)(it / NCG), cg = (int)(it % NCG), c0 = cg * 8, r0 = run * RUN, t0 = r0 & (SEQ - 1);
        float wg[3][8], wv[3][8], bg[8], bv[8];
#pragma unroll
        for (int k = 0; k < 3; ++k) { const f32x4 a = *(const f32x4*)(I.ffn_cw + (size_t)k * 2 * DFF + c0), b = *(const f32x4*)(I.ffn_cw + (size_t)k * 2 * DFF + c0 + 4);
            const f32x4 c = *(const f32x4*)(I.ffn_cw + (size_t)k * 2 * DFF + DFF + c0), d = *(const f32x4*)(I.ffn_cw + (size_t)k * 2 * DFF + DFF + c0 + 4);
#pragma unroll
            for (int e = 0; e < 4; ++e) { wg[k][e] = a[e]; wg[k][4 + e] = b[e]; wv[k][e] = c[e]; wv[k][4 + e] = d[e]; } }
        { const f32x4 a = *(const f32x4*)(I.ffn_cb + c0), b = *(const f32x4*)(I.ffn_cb + c0 + 4), c = *(const f32x4*)(I.ffn_cb + DFF + c0), d = *(const f32x4*)(I.ffn_cb + DFF + c0 + 4);
#pragma unroll
          for (int e = 0; e < 4; ++e) { bg[e] = a[e]; bg[4 + e] = b[e]; bv[e] = c[e]; bv[4 + e] = d[e]; } }
        float g2[8], g1[8], v2[8], v1[8];
#pragma unroll
        for (int e = 0; e < 8; ++e) { g2[e] = 0.f; g1[e] = 0.f; v2[e] = 0.f; v1[e] = 0.f; }
#define LOAD8(row, off, dst) do { const v4u q_ = *(const GAS v4u*)(UP + (size_t)(row) * (2 * DFF) + (off) + c0); \
        dst[0] = bflo(q_.x); dst[1] = bfhi(q_.x); dst[2] = bflo(q_.y); dst[3] = bfhi(q_.y); dst[4] = bflo(q_.z); dst[5] = bfhi(q_.z); dst[6] = bflo(q_.w); dst[7] = bfhi(q_.w); } while (0)
        if (t0 >= 2) { LOAD8(r0 - 2, 0, g2); LOAD8(r0 - 2, DFF, v2); LOAD8(r0 - 1, 0, g1); LOAD8(r0 - 1, DFF, v1); }
        for (int r = r0; r < r0 + RUN; r += 4) {
            v4u qg[4], qv[4];
#pragma unroll
            for (int q = 0; q < 4; ++q) { qg[q] = *(const GAS v4u*)(UP + (size_t)(r + q) * (2 * DFF) + c0); qv[q] = *(const GAS v4u*)(UP + (size_t)(r + q) * (2 * DFF) + DFF + c0); }
#pragma unroll
            for (int q = 0; q < 4; ++q) {
                float g0[8], v0[8];
                g0[0] = bflo(qg[q].x); g0[1] = bfhi(qg[q].x); g0[2] = bflo(qg[q].y); g0[3] = bfhi(qg[q].y); g0[4] = bflo(qg[q].z); g0[5] = bfhi(qg[q].z); g0[6] = bflo(qg[q].w); g0[7] = bfhi(qg[q].w);
                v0[0] = bflo(qv[q].x); v0[1] = bfhi(qv[q].x); v0[2] = bflo(qv[q].y); v0[3] = bfhi(qv[q].y); v0[4] = bflo(qv[q].z); v0[5] = bfhi(qv[q].z); v0[6] = bflo(qv[q].w); v0[7] = bfhi(qv[q].w);
                float o[8];
#pragma unroll
                for (int e = 0; e < 8; ++e) { const float ug = wg[0][e] * g2[e] + wg[1][e] * g1[e] + wg[2][e] * g0[e] + bg[e]; const float uv = wv[0][e] * v2[e] + wv[1][e] * v1[e] + wv[2][e] * v0[e] + bv[e];
                    o[e] = gelu_tanh_f(ug) * uv; g2[e] = g1[e]; g1[e] = g0[e]; v2[e] = v1[e]; v1[e] = v0[e]; }
                v4u w; w.x = pk2(o[0], o[1]); w.y = pk2(o[2], o[3]); w.z = pk2(o[4], o[5]); w.w = pk2(o[6], o[7]);
                *(GAS v4u*)(ACT + (size_t)(r + q) * DFF + c0) = w;
            }
        }
#undef LOAD8
    }
}
struct Args { In in; float* out; unsigned char* ws; int ph_lo, ph_hi; };
__global__ void __launch_bounds__(NWAVES * 64, 2) fwd_kernel(Args args) {
    extern __shared__ __attribute__((aligned(16))) unsigned char lds[];
    Frame F;
    F.lds = (LAS unsigned char*)lds;
    F.MISC = (volatile LAS unsigned*)(F.lds + MISC_OFF);
    F.tid = threadIdx.x; F.lane = F.tid & 63; F.wave = __builtin_amdgcn_readfirstlane(F.tid >> 6);
    F.G = gridDim.x; { const int bx = blockIdx.x; F.vcu = (F.G % 8 == 0) ? (bx % 8) * (F.G / 8) + bx / 8 : bx; }
    unsigned char* ws = args.ws;
    F.ctl = (gu32*)(ws + WS_CTL);
    const In& I = args.in;
    for (int u = F.tid; u < (LDS_BYTES - LDSCTL_OFF) / 4; u += NWAVES * 64) ((LAS unsigned*)(F.lds + LDSCTL_OFF))[u] = 0u;
    __syncthreads();
#if MK_PER_PHASE
#define GRID_BAR() do { } while (0)
#else
    XcdBarrier bar = xcd_barrier_post((unsigned*)(F.ctl + CW_BAR), F.MISC + 8);
#define GRID_BAR() xcd_barrier(bar)
#endif
    const int lo = args.ph_lo, hi = args.ph_hi;
#ifndef PHMASK
#define PHMASK 0x7fff
#endif
#define IN(k) (((PHMASK >> (k)) & 1) && lo <= (k) && (k) < hi)
#define BOTH(k) (IN(k) && IN((k) + 1))
#ifndef PROBE_REP
#define PROBE_REP 0
#endif
#define REP(k, ...) do { __VA_ARGS__; if ((PROBE_REP >> (k)) & 1) { GRID_BAR(); __VA_ARGS__; } } while (0)
    bf16* const Zb = (bf16*)(ws + WS_Z);
    bf16* const Hb = (bf16*)(ws + WS_H);
    float* const SSP1 = (float*)(ws + WS_SSP1); float* const SSP2 = (float*)(ws + WS_SSP2); float* const SSP3 = (float*)(ws + WS_SSP3);
    const Term T1{(const bf16*)(ws + WS_W1), SSP1}, T2{(const bf16*)(ws + WS_W2), SSP2}, T3{(const bf16*)(ws + WS_GE), SSP3};

    if (IN(0)) { REP(0, p0_prologue(F, I, ws)); if (BOTH(0)) GRID_BAR(); }

    if (IN(1)) {
        pg8::Gemm g{Hb, (const bf16*)(ws + WS_WIN), M, ZC + 256, DM}; pg8::StaticOrder S; S.init(M, ZC + 256, F.G, (int)blockIdx.x);
        pg8::EpiZ E{Zb, ZC, ZT, (float*)(ws + WS_FLT), M};
        REP(1, pg8::gemm_phase<pg8::EpiZ, pg8::StaticOrder, true, true>(F.lds + RING_OFF, g, S, E));
        if (BOTH(1)) GRID_BAR();
    }
    if (IN(2)) { REP(2, p2_conv_scan(F, I, ws)); if (BOTH(2)) GRID_BAR(); }

    if (IN(3)) {
        pg8::Gemm g{(const bf16*)(ws + WS_U), (const bf16*)(ws + WS_WA), M, DM, DM}; pg8::StaticOrder S; S.init(M, DM, F.G, (int)blockIdx.x);
        pg8::EpiGateA E{args.out, DM, Zb + Z_GA, ZC};
        REP(3, pg8::gemm_phase<pg8::EpiGateA, pg8::StaticOrder, true, true>(F.lds + RING_OFF, g, S, E));
    }
    if (IN(4)) {
        REP(4, fox::fox_phase<ZC, DM>((char*)lds + RING_OFF, Zb + Z_Q, Zb + Z_K, Zb + Z_V, (const float*)(ws + WS_NCB), (bf16*)(ws + WS_O), F.G, (int)blockIdx.x));
        if (BOTH(4)) GRID_BAR();
    }
    if (IN(5)) {
        pg8::Gemm g{(const bf16*)(ws + WS_O), (const bf16*)(ws + WS_WB), M, DM, DM}; pg8::StaticOrder S; S.init(M, DM, F.G, (int)blockIdx.x);
        pg8::EpiGateB E{(bf16*)(ws + WS_MM), args.out, DM, Zb + Z_GB, ZC};
        REP(5, pg8::gemm_phase<pg8::EpiGateB, pg8::StaticOrder, true, true>(F.lds + RING_OFF, g, S, E));
        if (BOTH(5)) GRID_BAR();
    }
    if (IN(6)) {
        pg8::Gemm g{(const bf16*)(ws + WS_MM), (const bf16*)(ws + WS_WOUT), M, DM, DM}; pg8::StaticOrder S; S.init(M, DM, F.G, (int)blockIdx.x);
        pg8::EpiSS E{(bf16*)(ws + WS_W1), DM, SSP1, NSLOT, I.g_mix_post};
        REP(6, pg8::gemm_phase<pg8::EpiSS, pg8::StaticOrder, true, true>(F.lds + RING_OFF, g, S, E));
        if (BOTH(6)) GRID_BAR();
    }
    if (IN(7)) { REP(7, rowwise_residual<1, true>(F, I.x, T1, T1, T1, Hb, nullptr)); if (BOTH(7)) GRID_BAR(); }

    if (IN(8)) {
        pg8::Gemm g{Hb, (const bf16*)(ws + WS_WUP), M, 2 * DFF, DM}; pg8::StaticOrder S; S.init(M, 2 * DFF, F.G, (int)blockIdx.x);
        pg8::EpiPlain E{(bf16*)(ws + WS_UP), 2 * DFF};
        REP(8, pg8::gemm_phase<pg8::EpiPlain, pg8::StaticOrder, true, true>(F.lds + RING_OFF, g, S, E));
        if (BOTH(8)) GRID_BAR();
    }
    if (IN(9)) { REP(9, p9_conv_gelu(F, I, ws)); if (BOTH(9)) GRID_BAR(); }

    if (IN(10)) {
        pg8::Gemm g{(const bf16*)(ws + WS_ACT), (const bf16*)(ws + WS_WDN), M, DM, DFF}; pg8::StaticOrder S; S.init(M, DM, F.G, (int)blockIdx.x);
        pg8::EpiSS E{(bf16*)(ws + WS_W2), DM, SSP2, NSLOT, I.g_ffn_post};
        REP(10, pg8::gemm_phase<pg8::EpiSS, pg8::StaticOrder, true, true>(F.lds + RING_OFF, g, S, E));
    }
    if (IN(11)) {
        pg8::Gemm g{(const bf16*)(ws + WS_PB), (const bf16*)(ws + WS_WPLE), M, DM, PLE}; pg8::StaticOrder S; S.init(M, DM, F.G, (int)blockIdx.x);
        pg8::EpiPlain E{(bf16*)(ws + WS_E), DM};
        REP(11, pg8::gemm_phase<pg8::EpiPlain, pg8::StaticOrder, true, true>(F.lds + RING_OFF, g, S, E));
        if (BOTH(11)) GRID_BAR();
    }
    if (IN(12)) { REP(12, rowwise_residual<2, true>(F, I.x, T1, T2, T2, Hb, nullptr)); if (BOTH(12)) GRID_BAR(); }

    if (IN(13)) {
        pg8::Gemm g{Hb, (const bf16*)(ws + WS_WPG), M, DM, DM}; pg8::StaticOrder S; S.init(M, DM, F.G, (int)blockIdx.x);
        pg8::EpiPle E{(bf16*)(ws + WS_GE), DM, (const bf16*)(ws + WS_E), SSP3, NSLOT, I.g_ple_post};
        REP(13, pg8::gemm_phase<pg8::EpiPle, pg8::StaticOrder, true, true>(F.lds + RING_OFF, g, S, E));
        if (BOTH(13)) GRID_BAR();
    }
    if (IN(14)) { REP(14, rowwise_residual<3, false>(F, I.x, T1, T2, T3, nullptr, args.out)); }
#undef IN
#undef BOTH
}

extern "C" void kernel_launch(void* const* d_in, const int* in_sizes, int n_in, void* d_out, int out_size, void* d_ws, size_t ws_size, hipStream_t stream) {
    static int grid = 0;
    if (grid == 0) {
        if (n_in != 20 || in_sizes[0] != M * DM || out_size != M * DM || ws_size < WS_END) { fprintf(stderr, "kernel_launch: shape/workspace mismatch: n_in %d in0 %d out %d ws %zu (need %zu)\n", n_in, n_in > 0 ? in_sizes[0] : -1, out_size, ws_size, (size_t)WS_END); grid = -1; return; }
        int dev = 0, cus = 0, per_cu = 0;
        if (hipGetDevice(&dev) != hipSuccess || hipDeviceGetAttribute(&cus, hipDeviceAttributeMultiprocessorCount, dev) != hipSuccess) { fprintf(stderr, "kernel_launch: device query failed\n"); grid = -1; return; }
        if (hipFuncSetAttribute((const void*)fwd_kernel, hipFuncAttributeMaxDynamicSharedMemorySize, LDS_BYTES) != hipSuccess) { fprintf(stderr, "kernel_launch: hipFuncSetAttribute failed\n"); grid = -1; return; }
        if (hipOccupancyMaxActiveBlocksPerMultiprocessor(&per_cu, (const void*)fwd_kernel, NWAVES * 64, LDS_BYTES) != hipSuccess || per_cu < 1)
            fprintf(stderr, "kernel_launch: note: occupancy query reports %d workgroups per CU\n", per_cu);
        (void)hipGetLastError();
        grid = cus;
    }
    if (grid < 0) return;
    if (hipMemsetAsync((char*)d_ws + WS_CTL, 0, CTL_ZERO_BYTES, stream) != hipSuccess) { fprintf(stderr, "kernel_launch: memset failed\n"); return; }
    Args a{};
    const float** ip = (const float**)&a.in;
    for (int i = 0; i < 20; ++i) ip[i] = (const float*)d_in[i];
    a.out = (float*)d_out; a.ws = (unsigned char*)d_ws;
#if MK_PER_PHASE
    for (int ph = 0; ph < N_PHASES; ++ph) { a.ph_lo = ph; a.ph_hi = ph + 1;
        hipLaunchKernelGGL(fwd_kernel, dim3(grid), dim3(NWAVES * 64), LDS_BYTES, stream, a); }
#else
    a.ph_lo = 0; a.ph_hi = N_PHASES;
    hipLaunchKernelGGL(fwd_kernel, dim3(grid), dim3(NWAVES * 64), LDS_BYTES, stream, a);
#endif
    const hipError_t le = hipPeekAtLastError();
    if (le != hipSuccess) fprintf(stderr, "kernel_launch: launch failed: %s\n", hipGetErrorName(le));
}
```

```cpp
#include <hip/hip_runtime.h>
#include <cstdio>
#include <cstdint>
#ifndef MK_PER_PHASE
#define MK_PER_PHASE 0
#endif
namespace pg8 {
#define PG8_LAS __attribute__((address_space(3)))
typedef unsigned short bf16_t;
typedef short bf16x8 __attribute__((ext_vector_type(8)));
typedef float f32x4 __attribute__((ext_vector_type(4)));
typedef unsigned u32x4 __attribute__((ext_vector_type(4)));
constexpr int BM = 256, BK = 64, HALF = 128, HTB = HALF * BK * 2  , STAGE_BYTES = 8 * HTB, NXCD = 8, WGM = 8;

__host__ __device__ __forceinline__ int lds_byte(int r, int c) { const int st = (r >> 4) * 2 + (c >> 5), rr = r & 15, cc = c & 31, ob = rr * 64 + cc * 2; return st * 1024 + (ob ^ (((ob >> 9) & 1) << 5)); }
__host__ __device__ __forceinline__ void stage_rc(int b, int& R, int& C) { const int st = b / 1024, sb = b % 1024, swz = sb ^ (((sb >> 9) & 1) << 5); R = (st >> 1) * 16 + swz / 64; C = (st & 1) * 32 + (swz % 64) / 2; }
__host__ __device__ __forceinline__ int perm32(int rho) { const int n = rho >> 4, i = rho & 15; return 8 * (i >> 2) + 4 * n + (i & 3); }

struct Unit { int pm, pn; };
struct Gemm { const bf16_t* A; const bf16_t* Bt; int M, N, K; };

struct StaticOrder {
    int nM, nN, nwg, G, c;
    __host__ __device__ void init(int M, int N, int G_, int c_) { nM = M / BM; nN = N / BM; nwg = nM * nN; G = G_; c = c_; }
    __host__ __device__ bool next(int i, Unit& u) const {
        const long L = (long)i * G + c; if (L >= nwg) return false;
        int wgid = (int)L; { const int q = nwg / NXCD, r = nwg % NXCD, xcd = wgid % NXCD, off = wgid / NXCD; wgid = (xcd < r ? xcd * (q + 1) : r * (q + 1) + (xcd - r) * q) + off; }
        const int nig = WGM * nN, gid = wgid / nig, fm = gid * WGM, gsz = (nM - fm) < WGM ? (nM - fm) : WGM;
        u.pm = fm + ((wgid % nig) % gsz); u.pn = (wgid % nig) / gsz; return true;
    }
    __device__ __forceinline__ void a_ready(const Unit&) const {}
    __device__ __forceinline__ void done(const Unit&) const {}
};

__device__ __forceinline__ unsigned cvt_pk_bf16(float lo, float hi) { unsigned r; asm volatile("v_cvt_pk_bf16_f32 %0, %1, %2" : "=v"(r) : "v"(lo), "v"(hi)); return r; }
__device__ __forceinline__ float fast_sigmoid(float x) { return __builtin_amdgcn_rcpf(1.0f + __builtin_amdgcn_exp2f(-1.4426950408889634f * x)); }
__device__ __forceinline__ float bf_lo(unsigned w) { return __uint_as_float(w << 16); }
__device__ __forceinline__ float bf_hi(unsigned w) { return __uint_as_float(w & 0xffff0000u); }
__device__ __forceinline__ u32x4 pack8(const f32x4 v0, const f32x4 v1) { u32x4 w; w.x = cvt_pk_bf16(v0[0], v0[1]); w.y = cvt_pk_bf16(v0[2], v0[3]); w.z = cvt_pk_bf16(v1[0], v1[1]); w.w = cvt_pk_bf16(v1[2], v1[3]); return w; }

struct EpiPlain {
    static constexpr bool PERM = true, AFTER_DRAIN = false;
    bf16_t* O; int ldc;
    __device__ __forceinline__ void operator()(const f32x4 (&acc)[2][2][4][2], const Unit& u, int wr, int wc, int fr, int fq) const {
        const int row0 = u.pm * BM + wr * 64 + fr, col0 = u.pn * BM + wc * 32 + 8 * fq;
#pragma unroll
        for (int ai = 0; ai < 2; ++ai)
#pragma unroll
            for (int m = 0; m < 4; ++m) { bf16_t* rowp = O + (size_t)(row0 + ai * HALF + m * 16) * ldc + col0;
#pragma unroll
                for (int bj = 0; bj < 2; ++bj) *(u32x4*)(rowp + bj * HALF) = pack8(acc[ai][bj][m][0], acc[ai][bj][m][1]); }
    }
};
struct EpiZ {
    static constexpr bool PERM = true, AFTER_DRAIN = false;
    bf16_t* Z; int ldz; int nzt; float* FLT; int M;
    __device__ __forceinline__ void operator()(const f32x4 (&acc)[2][2][4][2], const Unit& u, int wr, int wc, int fr, int fq) const {
        const int row0 = u.pm * BM + wr * 64 + fr;
        if (u.pn < nzt) {
            const int col0 = u.pn * BM + wc * 32 + 8 * fq;
#pragma unroll
            for (int ai = 0; ai < 2; ++ai)
#pragma unroll
                for (int m = 0; m < 4; ++m) { bf16_t* rowp = Z + (size_t)(row0 + ai * HALF + m * 16) * ldz + col0;
#pragma unroll
                    for (int bj = 0; bj < 2; ++bj) *(u32x4*)(rowp + bj * HALF) = pack8(acc[ai][bj][m][0], acc[ai][bj][m][1]); }
        } else if (wc == 0) {
#pragma unroll
            for (int ai = 0; ai < 2; ++ai)
#pragma unroll
                for (int m = 0; m < 4; ++m) { const int row = row0 + ai * HALF + m * 16;
#pragma unroll
                    for (int n = 0; n < 2; ++n)
#pragma unroll
                        for (int j = 0; j < 4; ++j) FLT[(size_t)(8 * fq + 4 * n + j) * M + row] = acc[ai][0][m][n][j]; }
        }
    }
};
struct EpiGateA {
    static constexpr bool PERM = true, AFTER_DRAIN = false;
    float* MA; int ldc; const bf16_t* G; int ldg;
    __device__ __forceinline__ void operator()(const f32x4 (&acc)[2][2][4][2], const Unit& u, int wr, int wc, int fr, int fq) const {
        const int row0 = u.pm * BM + wr * 64 + fr, col0 = u.pn * BM + wc * 32 + 8 * fq;
#pragma unroll
        for (int ai = 0; ai < 2; ++ai)
#pragma unroll
            for (int m = 0; m < 4; ++m) { const size_t row = (size_t)(row0 + ai * HALF + m * 16);
#pragma unroll
                for (int bj = 0; bj < 2; ++bj) { const u32x4 g = *(const u32x4*)(G + row * ldg + col0 + bj * HALF);
                    f32x4 v0 = acc[ai][bj][m][0], v1 = acc[ai][bj][m][1];
                    v0[0] *= fast_sigmoid(bf_lo(g.x)); v0[1] *= fast_sigmoid(bf_hi(g.x)); v0[2] *= fast_sigmoid(bf_lo(g.y)); v0[3] *= fast_sigmoid(bf_hi(g.y));
                    v1[0] *= fast_sigmoid(bf_lo(g.z)); v1[1] *= fast_sigmoid(bf_hi(g.z)); v1[2] *= fast_sigmoid(bf_lo(g.w)); v1[3] *= fast_sigmoid(bf_hi(g.w));
                    float* o = MA + row * ldc + col0 + bj * HALF; *(f32x4*)o = v0; *(f32x4*)(o + 4) = v1; } }
    }
};
struct EpiGateB {
    static constexpr bool PERM = true, AFTER_DRAIN = false;
    bf16_t* MM; const float* MA; int ldc; const bf16_t* G; int ldg;
    __device__ __forceinline__ void operator()(const f32x4 (&acc)[2][2][4][2], const Unit& u, int wr, int wc, int fr, int fq) const {
        const int row0 = u.pm * BM + wr * 64 + fr, col0 = u.pn * BM + wc * 32 + 8 * fq;
#pragma unroll
        for (int ai = 0; ai < 2; ++ai)
#pragma unroll
            for (int m = 0; m < 4; ++m) { const size_t row = (size_t)(row0 + ai * HALF + m * 16);
#pragma unroll
                for (int bj = 0; bj < 2; ++bj) { const u32x4 g = *(const u32x4*)(G + row * ldg + col0 + bj * HALF);
                    const float* a = MA + row * ldc + col0 + bj * HALF; const f32x4 a0 = *(const f32x4*)a, a1 = *(const f32x4*)(a + 4);
                    f32x4 v0 = acc[ai][bj][m][0], v1 = acc[ai][bj][m][1];
                    v0[0] = a0[0] + v0[0] * fast_sigmoid(bf_lo(g.x)); v0[1] = a0[1] + v0[1] * fast_sigmoid(bf_hi(g.x)); v0[2] = a0[2] + v0[2] * fast_sigmoid(bf_lo(g.y)); v0[3] = a0[3] + v0[3] * fast_sigmoid(bf_hi(g.y));
                    v1[0] = a1[0] + v1[0] * fast_sigmoid(bf_lo(g.z)); v1[1] = a1[1] + v1[1] * fast_sigmoid(bf_hi(g.z)); v1[2] = a1[2] + v1[2] * fast_sigmoid(bf_lo(g.w)); v1[3] = a1[3] + v1[3] * fast_sigmoid(bf_hi(g.w));
                    *(u32x4*)(MM + row * ldc + col0 + bj * HALF) = pack8(v0, v1); } }
    }
};
struct EpiSS {
    static constexpr bool PERM = true, AFTER_DRAIN = false;
    bf16_t* W; int ldc; float* SSP; int nslot; const float* gain;
    __device__ __forceinline__ void operator()(const f32x4 (&acc)[2][2][4][2], const Unit& u, int wr, int wc, int fr, int fq) const {
        const int row0 = u.pm * BM + wr * 64 + fr, col0 = u.pn * BM + wc * 32 + 8 * fq;
        f32x4 gv[2][2];
#pragma unroll
        for (int bj = 0; bj < 2; ++bj) { gv[bj][0] = *(const f32x4*)(gain + col0 + bj * HALF); gv[bj][1] = *(const f32x4*)(gain + col0 + bj * HALF + 4); }
#pragma unroll
        for (int ai = 0; ai < 2; ++ai)
#pragma unroll
            for (int m = 0; m < 4; ++m) { const size_t row = (size_t)(row0 + ai * HALF + m * 16); float s = 0.f;
#pragma unroll
                for (int bj = 0; bj < 2; ++bj) { const f32x4 v0 = acc[ai][bj][m][0], v1 = acc[ai][bj][m][1];
                    s += (v0[0] * v0[0] + v0[1] * v0[1]) + (v0[2] * v0[2] + v0[3] * v0[3]) + (v1[0] * v1[0] + v1[1] * v1[1]) + (v1[2] * v1[2] + v1[3] * v1[3]);
                    *(u32x4*)(W + row * ldc + col0 + bj * HALF) = pack8(v0 * gv[bj][0], v1 * gv[bj][1]); }
                s += __shfl_xor(s, 16); s += __shfl_xor(s, 32);
                if (fq == 0) SSP[row * nslot + 4 * u.pn + wc] = s; }
    }
};
struct EpiPle {
    static constexpr bool PERM = true, AFTER_DRAIN = false;
    bf16_t* GE; int ldc; const bf16_t* E; float* SSP; int nslot; const float* gain;
    __device__ __forceinline__ void operator()(const f32x4 (&acc)[2][2][4][2], const Unit& u, int wr, int wc, int fr, int fq) const {
        const int row0 = u.pm * BM + wr * 64 + fr, col0 = u.pn * BM + wc * 32 + 8 * fq;
        f32x4 gv[2][2];
#pragma unroll
        for (int bj = 0; bj < 2; ++bj) { gv[bj][0] = *(const f32x4*)(gain + col0 + bj * HALF); gv[bj][1] = *(const f32x4*)(gain + col0 + bj * HALF + 4); }
#pragma unroll
        for (int ai = 0; ai < 2; ++ai)
#pragma unroll
            for (int m = 0; m < 4; ++m) { const size_t row = (size_t)(row0 + ai * HALF + m * 16); float s = 0.f;
#pragma unroll
                for (int bj = 0; bj < 2; ++bj) { const u32x4 e = *(const u32x4*)(E + row * ldc + col0 + bj * HALF);
                    f32x4 v0 = acc[ai][bj][m][0], v1 = acc[ai][bj][m][1];
                    v0[0] = fast_sigmoid(v0[0]) * bf_lo(e.x); v0[1] = fast_sigmoid(v0[1]) * bf_hi(e.x); v0[2] = fast_sigmoid(v0[2]) * bf_lo(e.y); v0[3] = fast_sigmoid(v0[3]) * bf_hi(e.y);
                    v1[0] = fast_sigmoid(v1[0]) * bf_lo(e.z); v1[1] = fast_sigmoid(v1[1]) * bf_hi(e.z); v1[2] = fast_sigmoid(v1[2]) * bf_lo(e.w); v1[3] = fast_sigmoid(v1[3]) * bf_hi(e.w);
                    s += (v0[0] * v0[0] + v0[1] * v0[1]) + (v0[2] * v0[2] + v0[3] * v0[3]) + (v1[0] * v1[0] + v1[1] * v1[1]) + (v1[2] * v1[2] + v1[3] * v1[3]);
                    *(u32x4*)(GE + row * ldc + col0 + bj * HALF) = pack8(v0 * gv[bj][0], v1 * gv[bj][1]); }
                s += __shfl_xor(s, 16); s += __shfl_xor(s, 32);
                if (fq == 0) SSP[row * nslot + 4 * u.pn + wc] = s; }
    }
};
template <class Epi, class Sched, bool ALIGN_EPI = false, bool SP2 = false>
__device__ __forceinline__ void gemm_phase(PG8_LAS unsigned char* lds, const Gemm g, const Sched& S, const Epi& E) {
    const int tid = threadIdx.x, wid = __builtin_amdgcn_readfirstlane(tid >> 6), lane = tid & 63, wr = wid >> 2, wc = wid & 3, fr = lane & 15, fq = lane >> 4;
    const int K = g.K, nt = K / BK;
    unsigned voffA[2], voffB[2];
#pragma unroll
    for (int i = 0; i < 2; ++i) { int R, C; stage_rc(tid * 16 + i * 8192, R, C); const int Rb = Epi::PERM ? ((R & ~31) + perm32(R & 31)) : R;
        voffA[i] = (unsigned)(R * K + C) * 2u; voffB[i] = (unsigned)(Rb * K + C) * 2u; }
    const size_t kstep = (size_t)(BK * 2);
    const size_t hstep = (size_t)HALF * K * 2;
    const size_t tstep = 2 * hstep;
    const unsigned ldsw = (unsigned)wid * 1024u;
    const int aoff = lds_byte(wr * 64 + fr, fq * 8), boff = lds_byte(wc * 32 + fr, fq * 8);
#define PG8_SA(b, h) (((b) * 2 + (h)) * HTB)
#define PG8_SB(b, h) ((4 + (b) * 2 + (h)) * HTB)
#define PG8_STAGE(bufoff, gbase, voff) do { _Pragma("unroll") for (int _i = 0; _i < 2; ++_i) \
        __builtin_amdgcn_global_load_lds((const unsigned*)((const char*)(gbase) + (voff)[_i]), (PG8_LAS unsigned*)(lds + (bufoff) + ldsw + _i * 8192), 16, 0, 0); } while (0)
#define PG8_LDA(dst, b, h) do { _Pragma("unroll") for (int m = 0; m < 4; ++m) _Pragma("unroll") for (int k = 0; k < 2; ++k) dst[m][k] = *(const PG8_LAS bf16x8*)(lds + PG8_SA(b, h) + aoff + m * 2048 + k * 1024); } while (0)
#define PG8_LDB(dst, b, h) do { _Pragma("unroll") for (int n = 0; n < 2; ++n) _Pragma("unroll") for (int k = 0; k < 2; ++k) dst[n][k] = *(const PG8_LAS bf16x8*)(lds + PG8_SB(b, h) + boff + n * 2048 + k * 1024); } while (0)
#define PG8_MMA(ai, bj, At, Bt) do { __builtin_amdgcn_s_setprio(1); _Pragma("unroll") for (int m = 0; m < 4; ++m) _Pragma("unroll") for (int n = 0; n < 2; ++n) _Pragma("unroll") for (int k = 0; k < 2; ++k) \
        acc[ai][bj][m][n] = __builtin_amdgcn_mfma_f32_16x16x32_bf16(Bt[n][k], At[m][k], acc[ai][bj][m][n], 0, 0, 0); __builtin_amdgcn_s_setprio(0); } while (0)
#define PG8_WAIT_V(n) asm volatile("s_waitcnt vmcnt(" #n ")" ::: "memory")
#define PG8_WAIT_L(n) asm volatile("s_waitcnt lgkmcnt(" #n ")" ::: "memory")
#define PG8_BAR __builtin_amdgcn_s_barrier()
#define PG8_SCHED __builtin_amdgcn_sched_barrier(0)
    Unit cur, nxt; int ui = 0;
    if (!S.next(0, cur)) return;
    f32x4 acc[2][2][4][2];
#pragma unroll
    for (int a = 0; a < 2; ++a)
#pragma unroll
        for (int b = 0; b < 2; ++b)
#pragma unroll
            for (int m = 0; m < 4; ++m)
#pragma unroll
                for (int n = 0; n < 2; ++n) acc[a][b][m][n] = (f32x4){0.f, 0.f, 0.f, 0.f};
    bf16x8 At[4][2], B0[2][2], B1[2][2];
    const char* cA = (const char*)g.A + (size_t)cur.pm * tstep; const char* cB = (const char*)g.Bt + (size_t)cur.pn * tstep;
    S.a_ready(cur);
    if constexpr (SP2) {
        PG8_STAGE(PG8_SB(0, 0), cB, voffB); PG8_STAGE(PG8_SB(0, 1), cB + hstep, voffB); PG8_STAGE(PG8_SA(0, 0), cA, voffA); PG8_STAGE(PG8_SA(0, 1), cA + hstep, voffA);
        if (wr == 1) PG8_BAR;
        PG8_WAIT_V(2); PG8_BAR;
        PG8_STAGE(PG8_SB(1, 0), cB + kstep, voffB); PG8_STAGE(PG8_SA(1, 0), cA + kstep, voffA); PG8_STAGE(PG8_SB(1, 1), cB + hstep + kstep, voffB);
        PG8_WAIT_V(6); PG8_BAR;
    } else {
        PG8_STAGE(PG8_SB(0, 0), cB, voffB); PG8_STAGE(PG8_SA(0, 0), cA, voffA); PG8_STAGE(PG8_SB(0, 1), cB + hstep, voffB); PG8_STAGE(PG8_SA(0, 1), cA + hstep, voffA);
        if (wr == 1) PG8_BAR;
        PG8_WAIT_V(4); PG8_BAR;
        PG8_STAGE(PG8_SB(1, 0), cB + kstep, voffB); PG8_STAGE(PG8_SA(1, 0), cA + kstep, voffA); PG8_STAGE(PG8_SB(1, 1), cB + hstep + kstep, voffB);
        PG8_WAIT_V(6); PG8_BAR;
    }
    for (;;) {
        const bool has_next = S.next(ui + 1, nxt);
        const char* nA = has_next ? (const char*)g.A + (size_t)nxt.pm * tstep : cA; const char* nB = has_next ? (const char*)g.Bt + (size_t)nxt.pn * tstep : cB;
        for (int t = 0; t < nt; t += 2) {
            const bool last = (t == nt - 2);
            const char* a1 = cA + (size_t)(t + 1) * kstep;
            const char* a2 = last ? nA : cA + (size_t)(t + 2) * kstep; const char* b2 = last ? nB : cB + (size_t)(t + 2) * kstep;
            const char* a3 = a2 + kstep; const char* b3 = b2 + kstep;
            if (last && has_next) S.a_ready(nxt);
            if constexpr (SP2) {
            PG8_LDB(B0, 0, 0); PG8_LDB(B1, 0, 1); PG8_SCHED; PG8_LDA(At, 0, 0); PG8_STAGE(PG8_SA(1, 1), a1 + hstep, voffA);
            PG8_WAIT_V(8); PG8_WAIT_L(0); PG8_BAR; PG8_MMA(0, 0, At, B0); PG8_MMA(0, 1, At, B1); PG8_BAR; PG8_SCHED;
            PG8_LDA(At, 0, 1); PG8_STAGE(PG8_SB(0, 0), b2, voffB); PG8_STAGE(PG8_SB(0, 1), b2 + hstep, voffB); PG8_STAGE(PG8_SA(0, 0), a2, voffA);
            PG8_WAIT_V(8); PG8_WAIT_L(0); PG8_BAR; PG8_MMA(1, 0, At, B0); PG8_MMA(1, 1, At, B1); PG8_BAR; PG8_SCHED;
            PG8_LDB(B0, 1, 0); PG8_LDB(B1, 1, 1); PG8_SCHED; PG8_LDA(At, 1, 0); PG8_STAGE(PG8_SA(0, 1), a2 + hstep, voffA);
            PG8_WAIT_V(8); PG8_WAIT_L(0); PG8_BAR; PG8_MMA(0, 0, At, B0); PG8_MMA(0, 1, At, B1); PG8_BAR; PG8_SCHED;
            PG8_LDA(At, 1, 1); PG8_STAGE(PG8_SB(1, 0), b3, voffB); PG8_STAGE(PG8_SB(1, 1), b3 + hstep, voffB); PG8_STAGE(PG8_SA(1, 0), a3, voffA);
            PG8_WAIT_V(8); PG8_WAIT_L(0); PG8_BAR; PG8_MMA(1, 0, At, B0); PG8_MMA(1, 1, At, B1); PG8_BAR; PG8_SCHED;
            } else {
            PG8_LDB(B0, 0, 0); PG8_SCHED; PG8_LDA(At, 0, 0); PG8_STAGE(PG8_SA(1, 1), a1 + hstep, voffA);
            PG8_WAIT_L(8); PG8_BAR; PG8_WAIT_L(0); PG8_MMA(0, 0, At, B0); PG8_BAR; PG8_SCHED;
            PG8_LDB(B1, 0, 1); PG8_STAGE(PG8_SB(0, 0), b2, voffB);
            PG8_BAR; PG8_WAIT_L(0); PG8_MMA(0, 1, At, B1); PG8_BAR;
            PG8_LDA(At, 0, 1); PG8_STAGE(PG8_SA(0, 0), a2, voffA);
            PG8_BAR; PG8_WAIT_L(0); PG8_MMA(1, 0, At, B0); PG8_BAR; PG8_SCHED;
            PG8_STAGE(PG8_SB(0, 1), b2 + hstep, voffB);
            PG8_WAIT_V(6); PG8_BAR; PG8_MMA(1, 1, At, B1); PG8_BAR;
            PG8_LDB(B0, 1, 0); PG8_SCHED; PG8_LDA(At, 1, 0); PG8_STAGE(PG8_SA(0, 1), a2 + hstep, voffA);
            PG8_WAIT_L(8); PG8_BAR; PG8_WAIT_L(0); PG8_MMA(0, 0, At, B0); PG8_BAR; PG8_SCHED;
            PG8_LDB(B1, 1, 1); PG8_STAGE(PG8_SB(1, 0), b3, voffB);
            PG8_BAR; PG8_WAIT_L(0); PG8_MMA(0, 1, At, B1); PG8_BAR;
            PG8_LDA(At, 1, 1); PG8_STAGE(PG8_SA(1, 0), a3, voffA);
            PG8_BAR; PG8_WAIT_L(0); PG8_MMA(1, 0, At, B0); PG8_BAR; PG8_SCHED;
            PG8_STAGE(PG8_SB(1, 1), b3 + hstep, voffB);
            PG8_WAIT_V(6); PG8_BAR; PG8_MMA(1, 1, At, B1); PG8_BAR;
            }
        }
        if constexpr (ALIGN_EPI) { if (wr == 0) PG8_BAR; }
        if constexpr (!Epi::AFTER_DRAIN) { E(acc, cur, wr, wc, fr, fq); S.done(cur); }
        if (!has_next) break;
#pragma unroll
        for (int a = 0; a < 2; ++a)
#pragma unroll
            for (int b = 0; b < 2; ++b)
#pragma unroll
                for (int m = 0; m < 4; ++m)
#pragma unroll
                    for (int n = 0; n < 2; ++n) acc[a][b][m][n] = (f32x4){0.f, 0.f, 0.f, 0.f};
        cur = nxt; cA = nA; cB = nB; ++ui;
        if constexpr (ALIGN_EPI) { if (wr == 1) PG8_BAR; }
    }
    PG8_WAIT_V(0);
    if constexpr (!ALIGN_EPI) { if (wr == 0) PG8_BAR; }
    PG8_BAR;
    if constexpr (Epi::AFTER_DRAIN) { E.fused(acc, cur, wr, wc, fr, fq, lds, wid, lane); S.done(cur); }
#undef PG8_SA
#undef PG8_SB
#undef PG8_STAGE
#undef PG8_LDA
#undef PG8_LDB
#undef PG8_MMA
#undef PG8_WAIT_V
#undef PG8_WAIT_L
#undef PG8_BAR
#undef PG8_SCHED
}
}
namespace fox {
constexpr int D = 128, NW = 8, QBLK = 32, KVBLK = 64, QB = NW * QBLK;
constexpr int SHM_V = KVBLK * D * 2, SHM_K = KVBLK * D * 2;
constexpr int LDS_WS = 2 * SHM_V + 2 * SHM_K, LDS_BIAS = LDS_WS + NW * 64 * 4, LDS_BYTES = LDS_BIAS + 8192 * 4;
constexpr float SCALE = 0.08838834764831845f, THR = 8.f;
typedef unsigned short bf16;
typedef short bf16x8 __attribute__((ext_vector_type(8)));
typedef short s16x4 __attribute__((ext_vector_type(4)));
typedef float f32x16 __attribute__((ext_vector_type(16)));
typedef float f32x4 __attribute__((ext_vector_type(4)));
typedef unsigned u32x4 __attribute__((ext_vector_type(4)));
#define KSWZ(row, colB) ((row) * 256 + ((colB) ^ (((row) & 7) << 4)))
#define SBAR() __builtin_amdgcn_sched_barrier(0)
__device__ __forceinline__ int v_st(int k, int c) { const int kk = (k & ~0xC) | ((k & 4) << 1) | ((k & 8) >> 1); return ((kk >> 3) * 4 + (c >> 5)) * 512 + ((kk & 7) * 32 + (c & 31)) * 2; }
__device__ __forceinline__ int v_rd_base(int lane) { return ((lane & 3) << 3) | (((lane >> 2) & 3) << 6) | (((lane >> 4) & 1) << 5) | (((lane >> 5) & 1) << 8); }
constexpr int v_rd_off(int d0, int ks, int half) { return d0 * 512 + ks * 4096 + half * 2048; }
__device__ __forceinline__ int crow(int r, int hi) { return (r & 3) + 8 * (r >> 2) + 4 * hi; }
__device__ __forceinline__ unsigned cvtpk(float lo, float hi) { unsigned r; asm volatile("v_cvt_pk_bf16_f32 %0, %1, %2" : "=v"(r) : "v"(lo), "v"(hi)); return r; }
__device__ __forceinline__ bf16x8 load8(const bf16* p) { return *reinterpret_cast<const bf16x8*>(p); }
__device__ __forceinline__ void mask_tile(f32x16& p0, f32x16& p1, int dq) {
    const float NEG = -__builtin_inff();
#pragma unroll
    for (int r = 0; r < 16; ++r) { const int c = (r & 3) + 8 * (r >> 2);
        if (dq - c < 0) p0[r] = NEG;
        if (dq - c - 32 < 0) p1[r] = NEG; }
}
__device__ __forceinline__ void partialSM(f32x16& p0, f32x16& p1, float& m_reg, float& mn, float& alpha) {
    float pmax = p0[0];
#pragma unroll
    for (int r = 1; r < 16; ++r) pmax = fmaxf(pmax, p0[r]);
#pragma unroll
    for (int r = 0; r < 16; ++r) pmax = fmaxf(pmax, p1[r]);
    { auto rr = __builtin_amdgcn_permlane32_swap(__float_as_uint(pmax), __float_as_uint(pmax), false, false);
      pmax = fmaxf(__uint_as_float(rr[0]), __uint_as_float(rr[1])); }
    constexpr float C2 = 1.4426950408889634f * SCALE;
    if (__builtin_expect(__all((pmax - m_reg) * SCALE <= THR), 1)) { mn = m_reg; alpha = 1.f; }
    else { mn = fmaxf(m_reg, pmax); alpha = __builtin_amdgcn_exp2f((m_reg - mn) * C2); m_reg = mn; }
    const float mnL = -mn * C2;
#pragma unroll
    for (int r = 0; r < 16; ++r) p0[r] = fmaf(p0[r], C2, mnL);
#pragma unroll
    for (int r = 0; r < 16; ++r) p1[r] = fmaf(p1[r], C2, mnL);
#pragma unroll
    for (int r = 0; r < 16; ++r) p0[r] = __builtin_amdgcn_exp2f(p0[r]);
}
__device__ __forceinline__ void finishSM(f32x16& p0, f32x16& p1, float alpha, float& l_reg, bf16x8& pa0, bf16x8& pa1, bf16x8& pa2, bf16x8& pa3) {
#pragma unroll
    for (int r = 0; r < 16; ++r) p1[r] = __builtin_amdgcn_exp2f(p1[r]);
    float ps = 0;
#pragma unroll
    for (int r = 0; r < 16; ++r) ps += p0[r];
#pragma unroll
    for (int r = 0; r < 16; ++r) ps += p1[r];
    { auto rr = __builtin_amdgcn_permlane32_swap(__float_as_uint(ps), __float_as_uint(ps), false, false);
      ps = __uint_as_float(rr[0]) + __uint_as_float(rr[1]); }
    l_reg = l_reg * alpha + ps;
#define PK4(P, B_, OUT) do { unsigned a0 = cvtpk(P[B_+0], P[B_+1]), a1 = cvtpk(P[B_+2], P[B_+3]);                          \
        unsigned b0 = cvtpk(P[B_+4], P[B_+5]), b1 = cvtpk(P[B_+6], P[B_+7]);                                             \
        auto r0 = __builtin_amdgcn_permlane32_swap(a0, b0, false, false); auto r1 = __builtin_amdgcn_permlane32_swap(a1, b1, false, false); \
        u32x4 w = {r0[0], r1[0], r0[1], r1[1]}; OUT = *reinterpret_cast<bf16x8*>(&w); } while (0)
    PK4(p0, 0, pa0); PK4(p0, 8, pa1); PK4(p1, 0, pa2); PK4(p1, 8, pa3);
#undef PK4
}
template <int KB>
__device__ __forceinline__ void qkt(f32x16& p0, f32x16& p1, const char* K_lds, int r32, int hi, const bf16x8* qr, const float* bl) {
#pragma unroll
    for (int g = 0; g < 4; ++g) { const f32x4 a = *(const f32x4*)(bl + 8 * g), b = *(const f32x4*)(bl + 32 + 8 * g);
        p0[4 * g + 0] = a[0]; p0[4 * g + 1] = a[1]; p0[4 * g + 2] = a[2]; p0[4 * g + 3] = a[3];
        p1[4 * g + 0] = b[0]; p1[4 * g + 1] = b[1]; p1[4 * g + 2] = b[2]; p1[4 * g + 3] = b[3]; }
    const char* kb[4];
#pragma unroll
    for (int dd = 0; dd < 4; ++dd) kb[dd] = K_lds + KB * SHM_K + KSWZ(r32, (dd * 16 + hi * 8) * 2);
#pragma unroll
    for (int d0 = 0; d0 < 8; ++d0) { const char* a = kb[d0 & 3] + (d0 >> 2) * 128;
        bf16x8 b0 = *reinterpret_cast<const bf16x8*>(a);
        bf16x8 b1 = *reinterpret_cast<const bf16x8*>(a + 32 * 256);
        p0 = __builtin_amdgcn_mfma_f32_32x32x16_bf16(b0, qr[d0], p0, 0, 0, 0);
        p1 = __builtin_amdgcn_mfma_f32_32x32x16_bf16(b1, qr[d0], p1, 0, 0, 0); }
}
template <int VB>
__device__ __forceinline__ void pv_tile(f32x16* o, int vb0, bf16x8 pa0, bf16x8 pa1, bf16x8 pa2, bf16x8 pa3) {
#define TRRD(dst, off) asm volatile("ds_read_b64_tr_b16 %0, %1 offset:%2" : "=&v"(dst) : "v"(vb0), "i"(off) : "memory")
#define PV_D0(d0) do { s16x4 l0, l1, l2, l3, h0, h1, h2, h3; constexpr int b_ = VB * SHM_V + v_rd_off(d0, 0, 0); \
        TRRD(l0, b_); TRRD(h0, b_ + 2048); TRRD(l1, b_ + 4096); TRRD(h1, b_ + 6144); TRRD(l2, b_ + 8192); TRRD(h2, b_ + 10240); TRRD(l3, b_ + 12288); TRRD(h3, b_ + 14336); \
        asm volatile("s_waitcnt lgkmcnt(0)" ::: "memory"); SBAR();   \
        o[d0] = __builtin_amdgcn_mfma_f32_32x32x16_bf16(pa0, (bf16x8){l0[0], l0[1], l0[2], l0[3], h0[0], h0[1], h0[2], h0[3]}, o[d0], 0, 0, 0);   \
        o[d0] = __builtin_amdgcn_mfma_f32_32x32x16_bf16(pa1, (bf16x8){l1[0], l1[1], l1[2], l1[3], h1[0], h1[1], h1[2], h1[3]}, o[d0], 0, 0, 0);   \
        o[d0] = __builtin_amdgcn_mfma_f32_32x32x16_bf16(pa2, (bf16x8){l2[0], l2[1], l2[2], l2[3], h2[0], h2[1], h2[2], h2[3]}, o[d0], 0, 0, 0);   \
        o[d0] = __builtin_amdgcn_mfma_f32_32x32x16_bf16(pa3, (bf16x8){l3[0], l3[1], l3[2], l3[3], h3[0], h3[1], h3[2], h3[3]}, o[d0], 0, 0, 0); } while (0)
    PV_D0(0); PV_D0(1); PV_D0(2); PV_D0(3);
#undef PV_D0
#undef TRRD
}
struct BlockRef { const bf16* Q; const bf16* K; const bf16* V; bf16* O; int P0; };
struct Seam { bf16x8 qr[8]; bf16x8 st_v0, st_v1, st_k0, st_k1; };
#define VMW() asm volatile("s_waitcnt vmcnt(0)" ::: "memory")
#define VMWN(n) asm volatile("s_waitcnt vmcnt(%0)" :: "i"(n) : "memory")
#define LDG8(base, off) (*(const bf16x8*)((const char*)(base) + (off)))
#define SLOAD_H(Kp, Vp, k0) do { const bf16* vb_ = (Vp) + (size_t)(k0) * PIN; const bf16* kb_ = (Kp) + (size_t)(k0) * PIN;                        \
        S.st_v0 = LDG8(vb_, voff); S.st_v1 = LDG8(vb_ + (size_t)32 * PIN, voff); S.st_k0 = LDG8(kb_, voff); S.st_k1 = LDG8(kb_ + (size_t)32 * PIN, voff); } while (0)
#define SWRITE_HK(bf) do { *(bf16x8*)(K_lds + (bf) * SHM_K + kws) = S.st_k0; *(bf16x8*)(K_lds + (bf) * SHM_K + kws + 32 * 256) = S.st_k1; } while (0)
#define SWRITE_HV(bf) do { *(bf16x8*)(V_lds + (bf) * SHM_V + vst0) = S.st_v0; *(bf16x8*)(V_lds + (bf) * SHM_V + vst1) = S.st_v1; } while (0)
#define SWRITE_H(bf) do { SWRITE_HV(bf); SWRITE_HK(bf); } while (0)
template <int PIN>
__device__ __forceinline__ void fox_prime(const BlockRef& cur, char* lds, Seam& S) {
    const int tid = threadIdx.x, wid = __builtin_amdgcn_readfirstlane(tid >> 6), lane = tid & 63, r32 = lane & 31, hi = lane >> 5;
    const int sr = tid >> 4, sc = (tid & 15) * 8, kws = KSWZ(sr, sc * 2); char* K_lds = lds + 2 * SHM_V;
    const unsigned voff = (unsigned)(sr * PIN + sc) * 2u, qoff = (unsigned)(r32 * PIN + hi * 8) * 2u;
    { const bf16* qb_ = cur.Q + (size_t)(wid * QBLK) * PIN;
#pragma unroll
      for (int d0 = 0; d0 < 8; ++d0) S.qr[d0] = LDG8(qb_ + d0 * 16, qoff); }
    SLOAD_H(cur.K, cur.V, 0); VMW(); SWRITE_HK(0);
    __syncthreads();
}
template <int PIN, int POUT>
__device__ __forceinline__ void fox_block(const BlockRef& cur, const BlockRef& nxt, char* lds, Seam& S) {
    const int tid = threadIdx.x, wid = __builtin_amdgcn_readfirstlane(tid >> 6), lane = tid & 63, r32 = lane & 31, hi = lane >> 5;
    const int NT = (cur.P0 + QB - 1) / KVBLK + 1;
    const int qlo = cur.P0 + wid * QBLK, qm = qlo + r32 - 4 * hi;
    char* V_lds = lds; char* K_lds = lds + 2 * SHM_V;
    float* ws = (float*)(lds + LDS_WS) + wid * 64; float* li_l = ws, * al_l = ws + 32;
    const float* bias = (const float*)(lds + LDS_BIAS) + 4 * hi;
    float m_reg = -1e30f, l_reg = 0; f32x16 o[4] = {};
    const int sr = tid >> 4, sc = (tid & 15) * 8, vst0 = v_st(sr, sc), vst1 = v_st(32 + sr, sc), kws = KSWZ(sr, sc * 2);
    const unsigned voff = (unsigned)(sr * PIN + sc) * 2u, qoff = (unsigned)(r32 * PIN + hi * 8) * 2u;
    const int vb0 = (int)(uintptr_t)V_lds + v_rd_base(lane);
    const bf16* Kh = cur.K; const bf16* Vh = cur.V;
#define RESC(a) do { if (__any((a) < 1.f)) { if (hi == 0) al_l[r32] = (a); asm volatile("s_waitcnt lgkmcnt(0)" ::: "memory");              \
                     for (int d_ = 0; d_ < 4; ++d_) for (int r = 0; r < 16; ++r) o[d_][r] *= al_l[crow(r, hi)]; } } while (0)
#define KBASE(t) ((t) * KVBLK)
#define MASKT(P0_, P1_, t) do { const int kb_ = KBASE(t); if (kb_ + KVBLK - 1 > qlo) mask_tile(P0_, P1_, qm - kb_); } while (0)
    constexpr int NQL = 8;
#define SEAM_K0() do { VMWN(NQL); SWRITE_HK(0); SBAR(); } while (0)
    f32x16 pA0, pA1, pB0, pB1; float mnA, mnB, alA, alB; bf16x8 pa0, pa1, pa2, pa3;
    SWRITE_HV(0); SBAR();
    if (NT > 1) SLOAD_H(Kh, Vh, KBASE(1));
    SBAR(); qkt<0>(pA0, pA1, K_lds, r32, hi, S.qr, bias + KBASE(0));
    MASKT(pA0, pA1, 0); partialSM(pA0, pA1, m_reg, mnA, alA);
    if (NT > 1) { VMW(); SWRITE_H(1); }
    __syncthreads();
#define HALF_STEP(PX0, PX1, mnX, alX, PY0, PY1, alY, t, KB, VB, SB) do {                                                      \
        SBAR(); qkt<KB>(PX0, PX1, K_lds, r32, hi, S.qr, bias + KBASE(t));                                                     \
        finishSM(PY0, PY1, alY, l_reg, pa0, pa1, pa2, pa3); SBAR();                                                           \
        if ((t) + 1 < NT) { SLOAD_H(Kh, Vh, KBASE((t) + 1)); SBAR(); }                                                        \
        pv_tile<VB>(o, vb0, pa0, pa1, pa2, pa3); MASKT(PX0, PX1, (t)); partialSM(PX0, PX1, m_reg, mnX, alX);                  \
        __syncthreads();                                                                                                      \
        if ((t) + 1 < NT) { VMW(); SWRITE_H(SB); }                                                                            \
        RESC(alX); __syncthreads(); } while (0)
    for (int t = 1; t + 1 < NT; t += 2) {
        HALF_STEP(pB0, pB1, mnB, alB, pA0, pA1, alA, t, 1, 0, 0);
        HALF_STEP(pA0, pA1, mnA, alA, pB0, pB1, alB, t + 1, 0, 1, 1);
    }
    const bool even = (NT & 1) == 0;
    if (even) { SBAR(); qkt<1>(pB0, pB1, K_lds, r32, hi, S.qr, bias + KBASE(NT - 1)); SBAR(); }
    SLOAD_H(nxt.K, nxt.V, 0); SBAR();
    { const bf16* qb_ = nxt.Q + (size_t)(wid * QBLK) * PIN;
#pragma unroll
      for (int d0 = 0; d0 < 8; ++d0) S.qr[d0] = LDG8(qb_ + d0 * 16, qoff); }
    SBAR();
    finishSM(pA0, pA1, alA, l_reg, pa0, pa1, pa2, pa3); SBAR();
    pv_tile<0>(o, vb0, pa0, pa1, pa2, pa3);
    if (even) { MASKT(pB0, pB1, NT - 1); partialSM(pB0, pB1, m_reg, mnB, alB); __syncthreads(); RESC(alB);
        finishSM(pB0, pB1, alB, l_reg, pa0, pa1, pa2, pa3); SBAR(); pv_tile<1>(o, vb0, pa0, pa1, pa2, pa3); }
    SBAR(); SEAM_K0();
    if (hi == 0) li_l[r32] = l_reg; asm volatile("s_waitcnt lgkmcnt(0)" ::: "memory");
    float rli[16];
#pragma unroll
    for (int r = 0; r < 16; ++r) rli[r] = __builtin_amdgcn_rcpf(li_l[crow(r, hi)]);
    bf16* Ow = cur.O + (size_t)(wid * QBLK) * POUT;
#pragma unroll
    for (int r = 0; r < 16; ++r) { const int orow = crow(r, hi);
#pragma unroll
        for (int d0 = 0; d0 < 4; ++d0) { const float v = o[d0][r] * rli[r];
            const float vn = __shfl_xor(v, 1);
            if ((r32 & 1) == 0) *(unsigned*)(Ow + (size_t)orow * POUT + d0 * 32 + r32) = cvtpk(v, vn); } }
    __syncthreads();
#undef RESC
#undef KBASE
#undef MASKT
#undef SEAM_K0
#undef HALF_STEP
}
#undef LDG8
#undef VMW
#undef VMWN
#undef SLOAD_H
#undef SWRITE_HK
#undef SWRITE_HV
#undef SWRITE_H
template <int PIN, int POUT>
__device__ __forceinline__ void fox_phase(char* lds, const bf16* Zq, const bf16* Zk, const bf16* Zv, const float* NCB, bf16* O, int G, int w) {
    constexpr int SEQ = 8192, NH = 32, NQB = SEQ / QB, NX = NQB / 2, TOTAL = 2 * NH * NX;
    int L = w; if (L >= TOTAL) return;
    const int tid = threadIdx.x;
    int pass = 0;
#define DECODE(L_, bh_, x_) do { bh_ = ((L_) >> 7) * 8 + ((L_) & 7); x_ = ((L_) >> 3) & 15; } while (0)
#define MKREF(r_, bh_, qb_) do { const int b_ = (bh_) >> 5, h_ = (bh_) & 31; const size_t row0_ = (size_t)b_ * SEQ; \
        r_.Q = Zq + (row0_ + (size_t)(qb_) * QB) * PIN + h_ * D; r_.K = Zk + row0_ * PIN + h_ * D; r_.V = Zv + row0_ * PIN + h_ * D; \
        r_.O = O + (row0_ + (size_t)(qb_) * QB) * POUT + h_ * D; r_.P0 = (qb_) * QB; } while (0)
    int bh, x; DECODE(L, bh, x);
    BlockRef cur; MKREF(cur, bh, x);
    Seam S;
    { const f32x4* src = (const f32x4*)(NCB + (size_t)bh * SEQ); f32x4* dst = (f32x4*)(lds + LDS_BIAS); const int n4 = (NQB - x) * QB / 4;
      for (int i = tid; i < n4; i += NW * 64) dst[i] = src[i]; }
    fox_prime<PIN>(cur, lds, S);
    for (;;) {
        const bool more_pass = pass == 0, more_item = L + G < TOTAL, last = !more_pass && !more_item;
        int bhn = bh, xn = x, passn = pass + 1, Ln = L;
        if (!more_pass) { passn = 0; Ln = more_item ? L + G : L; DECODE(Ln, bhn, xn); }
        BlockRef nxt; if (last) nxt = cur; else MKREF(nxt, bhn, passn ? NQB - 1 - xn : xn);
        fox_block<PIN, POUT>(cur, nxt, lds, S);
        if (last) break;
        if (!more_pass) { const f32x4* src = (const f32x4*)(NCB + (size_t)bhn * SEQ); f32x4* dst = (f32x4*)(lds + LDS_BIAS); const int n4 = (NQB - xn) * QB / 4;
            for (int i = tid; i < n4; i += NW * 64) dst[i] = src[i];
            __syncthreads(); }
        cur = nxt; bh = bhn; x = xn; pass = passn; L = Ln;
    }
#undef DECODE
#undef MKREF
}
#undef KSWZ
#undef SBAR
}
constexpr int NWAVES = 8;
constexpr int BATCH = 2, SEQ = 8192, DM = 4096, NH = 32, HD = 128, DFF = 11008, PLE = 256;
constexpr int M = BATCH * SEQ;
constexpr int INC = 8 * DM + NH;
constexpr int ZC = 8 * DM;
constexpr int ZT = ZC / 256;
constexpr int Z_CB = 0, Z_CC = DM, Z_CV = 2 * DM, Z_Q = 3 * DM, Z_K = 4 * DM, Z_V = 5 * DM, Z_GA = 6 * DM, Z_GB = 7 * DM;
constexpr int NSLOT = 64;
constexpr float EPS = 1e-6f;
constexpr int N_PHASES = 15;

constexpr size_t MiB = 1u << 20;
constexpr size_t WS_CTL = 0, CTL_ZERO_BYTES = 1 * MiB;
constexpr size_t WS_FLT = 1 * MiB;
constexpr size_t WS_NCB = 3 * MiB;
constexpr size_t WS_SSP1 = 5 * MiB;
constexpr size_t WS_WA = 9 * MiB, WS_WB = 41 * MiB, WS_WOUT = 73 * MiB, WS_WPG = 105 * MiB, WS_WPLE = 137 * MiB;
constexpr size_t WS_PB = 139 * MiB;
constexpr size_t WS_WUP = 147 * MiB;
constexpr size_t WS_WDN = 319 * MiB;
constexpr size_t WS_WIN = 405 * MiB;
constexpr size_t WS_U = WS_WIN, WS_O = WS_WIN + 128 * MiB;
constexpr size_t WS_W1 = WS_U;
constexpr size_t WS_E = WS_O;
constexpr size_t WS_H = 663 * MiB;
constexpr size_t WS_MM = WS_H;
constexpr size_t WS_Z = 791 * MiB;
constexpr size_t WS_UP = WS_Z, WS_ACT = WS_Z + 688 * MiB;
constexpr size_t WS_W2 = WS_Z;
constexpr size_t WS_GE = WS_Z + 128 * MiB;
constexpr size_t WS_SSP2 = WS_Z + 1032 * MiB, WS_SSP3 = WS_SSP2 + 4 * MiB;
constexpr size_t WS_END = WS_SSP3 + 4 * MiB;
static_assert(WS_WPLE + (size_t)DM * PLE * 2 <= WS_PB && WS_PB + (size_t)M * PLE * 2 <= WS_WUP && WS_WUP + (size_t)2 * DFF * DM * 2 <= WS_WDN && WS_WDN + (size_t)DM * DFF * 2 <= WS_WIN, "ws map 1");
static_assert(WS_WIN + (size_t)(ZC + 256) * DM * 2 <= WS_H && WS_H + (size_t)M * DM * 2 <= WS_Z && WS_Z + (size_t)M * ZC * 2 <= WS_END && WS_ACT + (size_t)M * DFF * 2 <= WS_END && WS_UP + (size_t)M * 2 * DFF * 2 <= WS_ACT, "ws map 2");
constexpr int CW_TMO = 0, CW_CODE = 1;
constexpr int CW_BAR = 4096;

constexpr int RING_OFF = 0, RING_BYTES = 131072;
constexpr int LDSCTL_OFF = RING_BYTES, MISC_OFF = LDSCTL_OFF + 320;
constexpr int LDS_BYTES = 147456;
static_assert(MISC_OFF + 128 <= LDS_BYTES && fox::LDS_BYTES <= RING_BYTES, "LDS map");

#define GAS __attribute__((address_space(1)))
#define LAS __attribute__((address_space(3)))
typedef unsigned short bf16;
typedef unsigned v4u __attribute__((ext_vector_type(4)));
typedef unsigned v2u __attribute__((ext_vector_type(2)));
typedef float f32x4 __attribute__((ext_vector_type(4)));
typedef GAS unsigned gu32;
#define RLX_AGENT __ATOMIC_RELAXED, __HIP_MEMORY_SCOPE_AGENT
#define LDS_WAIT() asm volatile("s_waitcnt lgkmcnt(0)" ::: "memory")
#define VM_WAIT() asm volatile("s_waitcnt vmcnt(0)" ::: "memory")
__device__ __forceinline__ unsigned f2bf(float f) { unsigned u = __builtin_bit_cast(unsigned, f); return (u + 0x7fffu + ((u >> 16) & 1u)) >> 16; }
__device__ __forceinline__ unsigned pk2(float lo, float hi) { return f2bf(lo) | (f2bf(hi) << 16); }
__device__ __forceinline__ float bflo(unsigned w) { return __uint_as_float(w << 16); }
__device__ __forceinline__ float bfhi(unsigned w) { return __uint_as_float(w & 0xffff0000u); }
#define XB_TMO      128
#define XB_XCNT(j)  (256  + 64 * (j))
#define XB_XSUB(j)  (1280 + 64 * (j))
#define XB_XGEN(j)  (2304 + 64 * (j))
#define XB_TOP      3328
#define XB_TOPGEN   3392
#define XCD_BAR_WORDS 3456
#define XB_SPIN_CAP (1u << 18)

__device__ __forceinline__ unsigned xb_ld(unsigned* p)              { return __hip_atomic_load(p, __ATOMIC_RELAXED, __HIP_MEMORY_SCOPE_AGENT); }
__device__ __forceinline__ unsigned xb_add(unsigned* p, unsigned v) { return __hip_atomic_fetch_add(p, v, __ATOMIC_RELAXED, __HIP_MEMORY_SCOPE_AGENT); }
__device__ __forceinline__ unsigned xb_xcc_id() { return (unsigned)__builtin_amdgcn_s_getreg((3 << 11) | 20) & 0xFu; }
#define XB_SPIN(cond, bar) do { unsigned _sp = 0; while (cond) { __builtin_amdgcn_s_sleep(1); \
    if ((++_sp & 255u) == 0u) { if (xb_ld(&(bar)[XB_TMO])) break; if (_sp > XB_SPIN_CAP) { atomicAdd(&(bar)[XB_TMO], 1u); break; } } } } while (0)

struct XcdBarrier {
    unsigned* bar; unsigned x;
    volatile LAS unsigned* st;
};

__device__ __forceinline__ XcdBarrier xcd_barrier_post(unsigned* bar, volatile LAS unsigned* st) {
    XcdBarrier b; b.bar = bar; b.x = xb_xcc_id(); b.st = st;
    if (threadIdx.x == 0) (void)xb_add(&bar[XB_XCNT(b.x)], 1u);
    return b;
}
__device__ __forceinline__ void xcd_barrier_complete(unsigned* bar, unsigned x, unsigned& nloc, unsigned& nx) {
    const unsigned G = gridDim.x * gridDim.y * gridDim.z;
    unsigned sum, cnt, mine, sp = 0u;
    for (;;) {
        sum = 0u; cnt = 0u; mine = 0u;
#pragma unroll
        for (unsigned j = 0; j < 16; ++j) { const unsigned c = xb_ld(&bar[XB_XCNT(j)]); sum += c; cnt += (c > 0u) ? 1u : 0u; mine = (j == x) ? c : mine; }
        if (sum == G) break;
        __builtin_amdgcn_s_sleep(1);
        if ((++sp & 255u) == 0u) { if (xb_ld(&bar[XB_TMO])) break; if (sp > XB_SPIN_CAP) { atomicAdd(&bar[XB_TMO], 1u); break; } }
    }
    nloc = mine > 0u ? mine : 1u; nx = cnt > 0u ? cnt : 1u;
}

__device__ __forceinline__ void xcd_barrier(const XcdBarrier& b) {
    asm volatile("s_waitcnt vmcnt(0)" ::: "memory");
    __syncthreads();
    if (threadIdx.x == 0) {
        unsigned* bar = b.bar;
        __builtin_amdgcn_s_waitcnt(0);
        unsigned nloc = b.st[0], nx = b.st[1];
        if (nloc == 0u) { xcd_barrier_complete(bar, b.x, nloc, nx); b.st[0] = nloc; b.st[1] = nx; }
        const unsigned old = xb_add(&bar[XB_XSUB(b.x)], 1u);
        const unsigned gen = old / nloc;
        if (old + 1u == (gen + 1u) * nloc) {
            __builtin_amdgcn_fence(__ATOMIC_RELEASE, "agent");
            asm volatile("s_waitcnt vmcnt(0)" ::: "memory");
            const unsigned og = xb_add(&bar[XB_TOP], 1u);
            const unsigned tg = og / nx;
            if (og + 1u == (tg + 1u) * nx) xb_add(&bar[XB_TOPGEN], 1u);
            else XB_SPIN(xb_ld(&bar[XB_TOPGEN]) == tg, bar);
            __builtin_amdgcn_fence(__ATOMIC_ACQUIRE, "agent");
            xb_add(&bar[XB_XGEN(b.x)], 1u);
            asm volatile("s_waitcnt vmcnt(0)" ::: "memory");
        } else {
            XB_SPIN(xb_ld(&bar[XB_XGEN(b.x)]) == gen, bar);
            __builtin_amdgcn_fence(__ATOMIC_ACQUIRE, "agent");
            asm volatile("s_waitcnt vmcnt(0)" ::: "memory");
        }
    }
    __syncthreads();
}

struct Frame {
    LAS unsigned char* lds;
    volatile LAS unsigned* MISC;
    gu32* ctl;
    int tid, lane, wave;
    int vcu, G;
};
__device__ __forceinline__ float wave_sum(float v) {
#pragma unroll
    for (int o = 1; o < 64; o <<= 1) v += __shfl_xor(v, o);
    return v;
}
__device__ __forceinline__ void p0_transpose_item(const float* W, int K, int ldw, int col_off, int nblk, bf16* WT, int row_off, LAS float* scr, int item, int lane, const float* gain) {
    const int kb = item / nblk, nb = item % nblk, k0 = 64 * kb, n0 = 32 * nb;
#pragma unroll 8
    for (int i = 0; i < 32; ++i) { const int kk = 2 * i + (lane >> 5); scr[kk * 33 + (lane & 31)] = W[(size_t)(k0 + kk) * ldw + col_off + n0 + (lane & 31)]; }
    LDS_WAIT(); asm volatile("" ::: "memory");
    const int c = lane & 7;
    f32x4 g0 = {1.f, 1.f, 1.f, 1.f}, g1 = g0;
    if (gain) { g0 = *(const f32x4*)(gain + k0 + 8 * c); g1 = *(const f32x4*)(gain + k0 + 8 * c + 4); }
#pragma unroll
    for (int j = 0; j < 4; ++j) { const int n = (lane >> 3) + 8 * j; const LAS float* s = scr + (8 * c) * 33 + n;
        v4u o; o.x = pk2(s[0 * 33] * g0.x, s[1 * 33] * g0.y); o.y = pk2(s[2 * 33] * g0.z, s[3 * 33] * g0.w); o.z = pk2(s[4 * 33] * g1.x, s[5 * 33] * g1.y); o.w = pk2(s[6 * 33] * g1.z, s[7 * 33] * g1.w);
        *(GAS v4u*)(WT + (size_t)(row_off + n0 + n) * K + k0 + 8 * c) = o; }
    LDS_WAIT(); asm volatile("" ::: "memory");
}
__device__ __forceinline__ void rms_row_to_bf16(int lane, const float* xrow, bf16* orow) {
    const GAS f32x4* xr = (const GAS f32x4*)xrow + lane;
    f32x4 v[16]; float s = 0.f;
#pragma unroll
    for (int j = 0; j < 16; ++j) { v[j] = xr[64 * j]; s += (v[j].x * v[j].x + v[j].y * v[j].y) + (v[j].z * v[j].z + v[j].w * v[j].w); }
    const float inv = 1.f / sqrtf(wave_sum(s) * (1.f / DM) + EPS);
    GAS v2u* o8 = (GAS v2u*)orow + lane;
#pragma unroll
    for (int j = 0; j < 16; ++j) { v2u w; w.x = pk2(v[j].x * inv, v[j].y * inv); w.y = pk2(v[j].z * inv, v[j].w * inv); o8[64 * j] = w; }
}
struct In { const float *x, *p, *g_mix_pre, *w_in, *fbias, *conv_w, *w_a, *w_b, *w_out, *g_mix_post, *g_ffn_pre, *w_up, *ffn_cw, *ffn_cb, *w_down, *g_ffn_post, *w_ple, *g_ple_gate, *w_pg, *g_ple_post; };

__device__ __forceinline__ void p0_prologue(Frame& F, const In& I, unsigned char* ws) {
    LAS float* scr = (LAS float*)(F.lds + RING_OFF + F.wave * 16384);
    const int gw = F.vcu * NWAVES + F.wave, NGW = F.G * NWAVES;
    bf16* WIN = (bf16*)(ws + WS_WIN);
    constexpr int KB4 = DM / 64;
    constexpr int I_IN1 = KB4 * (6 * DM / 32), I_INF = KB4 * 1, I_IN2 = KB4 * (2 * DM / 32);
    constexpr int I_SQ = KB4 * (DM / 32);
    constexpr int I_UP = KB4 * (2 * DFF / 32), I_DN = (DFF / 64) * (DM / 32), I_PLE = (PLE / 64) * (DM / 32);
    constexpr int NITEMS = I_IN1 + I_INF + I_IN2 + 4 * I_SQ + I_UP + I_DN + I_PLE;
    for (int it = gw; it < NITEMS; it += NGW) {
        int r = it;
        if (r < I_IN1) { p0_transpose_item(I.w_in, DM, INC, 0, 6 * DM / 32, WIN, 0, scr, r, F.lane, I.g_mix_pre); continue; } r -= I_IN1;
        if (r < I_INF) { p0_transpose_item(I.w_in, DM, INC, 6 * DM, 1, WIN, ZC, scr, r, F.lane, I.g_mix_pre); continue; } r -= I_INF;
        if (r < I_IN2) { p0_transpose_item(I.w_in, DM, INC, 6 * DM + NH, 2 * DM / 32, WIN, 6 * DM, scr, r, F.lane, I.g_mix_pre); continue; } r -= I_IN2;
        if (r < I_SQ) { p0_transpose_item(I.w_a, DM, DM, 0, DM / 32, (bf16*)(ws + WS_WA), 0, scr, r, F.lane, nullptr); continue; } r -= I_SQ;
        if (r < I_SQ) { p0_transpose_item(I.w_b, DM, DM, 0, DM / 32, (bf16*)(ws + WS_WB), 0, scr, r, F.lane, nullptr); continue; } r -= I_SQ;
        if (r < I_SQ) { p0_transpose_item(I.w_out, DM, DM, 0, DM / 32, (bf16*)(ws + WS_WOUT), 0, scr, r, F.lane, nullptr); continue; } r -= I_SQ;
        if (r < I_SQ) { p0_transpose_item(I.w_pg, DM, DM, 0, DM / 32, (bf16*)(ws + WS_WPG), 0, scr, r, F.lane, I.g_ple_gate); continue; } r -= I_SQ;
        if (r < I_UP) { p0_transpose_item(I.w_up, DM, 2 * DFF, 0, 2 * DFF / 32, (bf16*)(ws + WS_WUP), 0, scr, r, F.lane, I.g_ffn_pre); continue; } r -= I_UP;
        if (r < I_DN) { p0_transpose_item(I.w_down, DFF, DM, 0, DM / 32, (bf16*)(ws + WS_WDN), 0, scr, r, F.lane, nullptr); continue; } r -= I_DN;
        p0_transpose_item(I.w_ple, PLE, DM, 0, DM / 32, (bf16*)(ws + WS_WPLE), 0, scr, r, F.lane, nullptr);
    }
    bf16* H = (bf16*)(ws + WS_H);
    for (int m = gw; m < M; m += NGW) rms_row_to_bf16(F.lane, I.x + (size_t)m * DM, H + (size_t)m * DM);
    { const GAS f32x4* src = (const GAS f32x4*)I.p; GAS v2u* dst = (GAS v2u*)(ws + WS_PB); const size_t n4 = (size_t)M * PLE / 4;
      for (size_t i = (size_t)gw * 64 + F.lane; i < n4; i += (size_t)NGW * 64) { const f32x4 v = src[i]; v2u w; w.x = pk2(v.x, v.y); w.y = pk2(v.z, v.w); dst[i] = w; } }
}

__device__ __forceinline__ float log_sigmoid_f(float x) { return fminf(x, 0.f) - log1pf(expf(-fabsf(x))); }
__device__ __forceinline__ void p2_conv_scan(Frame& F, const In& I, unsigned char* ws) {
    const bf16* Z = (const bf16*)(ws + WS_Z); bf16* U = (bf16*)(ws + WS_U);
    const int gw = F.vcu * NWAVES + F.wave;
    if (gw < BATCH * NH) {
        const int b = gw >> 5, h = gw & 31; const float fb = I.fbias[h];
        const GAS f32x4* src = (const GAS f32x4*)((const float*)(ws + WS_FLT) + (size_t)h * M + (size_t)b * SEQ) + F.lane;
        GAS f32x4* dst = (GAS f32x4*)((float*)(ws + WS_NCB) + (size_t)gw * SEQ) + F.lane;
        float carry = 0.f; const float k = -11.313708498984761f;
        for (int i = 0; i < SEQ / 256; ++i) {
            const f32x4 v = src[64 * i];
            const float s0 = log_sigmoid_f(v.x + fb), s1 = s0 + log_sigmoid_f(v.y + fb), s2 = s1 + log_sigmoid_f(v.z + fb), s3 = s2 + log_sigmoid_f(v.w + fb);
            float inc = s3;
#pragma unroll
            for (int o = 1; o < 64; o <<= 1) { const float t = __shfl_up(inc, o); if (F.lane >= o) inc += t; }
            const float base = carry + (inc - s3);
            f32x4 c; c.x = (base + s0) * k; c.y = (base + s1) * k; c.z = (base + s2) * k; c.w = (base + s3) * k;
            dst[64 * i] = c;
            carry += __shfl(inc, 63);
        }
    }
    const int c0 = (F.wave * 64 + F.lane) * 8;
    f32x4 w0a, w0b, w1a, w1b, w2a, w2b;
    { const float* cw = I.conv_w; w0a = *(const f32x4*)(cw + c0); w0b = *(const f32x4*)(cw + c0 + 4); w1a = *(const f32x4*)(cw + DM + c0); w1b = *(const f32x4*)(cw + DM + c0 + 4);
      w2a = *(const f32x4*)(cw + 2 * DM + c0); w2b = *(const f32x4*)(cw + 2 * DM + c0 + 4); }
    constexpr int RUN = 32;
    for (int run = F.vcu; run < M / RUN; run += F.G) {
        const int r0 = run * RUN; const int t0 = r0 & (SEQ - 1);
        f32x4 p2a = {0.f, 0.f, 0.f, 0.f}, p2b = p2a, p1a = p2a, p1b = p2a;
#define LOADPROD(row, A, B) do { const v4u cc = *(const GAS v4u*)(Z + (size_t)(row) * ZC + Z_CC + c0), cv = *(const GAS v4u*)(Z + (size_t)(row) * ZC + Z_CV + c0); \
        A.x = bflo(cc.x) * bflo(cv.x); A.y = bfhi(cc.x) * bfhi(cv.x); A.z = bflo(cc.y) * bflo(cv.y); A.w = bfhi(cc.y) * bfhi(cv.y); \
        B.x = bflo(cc.z) * bflo(cv.z); B.y = bfhi(cc.z) * bfhi(cv.z); B.z = bflo(cc.w) * bflo(cv.w); B.w = bfhi(cc.w) * bfhi(cv.w); } while (0)
        if (t0 >= 2) { LOADPROD(r0 - 2, p2a, p2b); LOADPROD(r0 - 1, p1a, p1b); }
        for (int r = r0; r < r0 + RUN; r += 4) {
            v4u cc4[4], cv4[4], cb4[4];
#pragma unroll
            for (int q = 0; q < 4; ++q) { cc4[q] = *(const GAS v4u*)(Z + (size_t)(r + q) * ZC + Z_CC + c0); cv4[q] = *(const GAS v4u*)(Z + (size_t)(r + q) * ZC + Z_CV + c0); cb4[q] = *(const GAS v4u*)(Z + (size_t)(r + q) * ZC + Z_CB + c0); }
#pragma unroll
            for (int q = 0; q < 4; ++q) {
                const v4u cc = cc4[q], cv = cv4[q], cb = cb4[q]; f32x4 pa, pb;
                pa.x = bflo(cc.x) * bflo(cv.x); pa.y = bfhi(cc.x) * bfhi(cv.x); pa.z = bflo(cc.y) * bflo(cv.y); pa.w = bfhi(cc.y) * bfhi(cv.y);
                pb.x = bflo(cc.z) * bflo(cv.z); pb.y = bfhi(cc.z) * bfhi(cv.z); pb.z = bflo(cc.w) * bflo(cv.w); pb.w = bfhi(cc.w) * bfhi(cv.w);
                const f32x4 ya = w0a * p2a + w1a * p1a + w2a * pa, yb = w0b * p2b + w1b * p1b + w2b * pb;
                v4u o; o.x = pk2(bflo(cb.x) * ya.x, bfhi(cb.x) * ya.y); o.y = pk2(bflo(cb.y) * ya.z, bfhi(cb.y) * ya.w);
                o.z = pk2(bflo(cb.z) * yb.x, bfhi(cb.z) * yb.y); o.w = pk2(bflo(cb.w) * yb.z, bfhi(cb.w) * yb.w);
                *(GAS v4u*)(U + (size_t)(r + q) * DM + c0) = o;
                p2a = p1a; p2b = p1b; p1a = pa; p1b = pb;
            }
        }
#undef LOADPROD
    }
}

struct Term { const bf16* W; const float* SSP; };
typedef int v4i __attribute__((ext_vector_type(4)));
typedef int v2i __attribute__((ext_vector_type(2)));
#define MKRSRC(p, nbytes) __builtin_amdgcn_make_buffer_rsrc((void*)(p), (short)0, (int)(nbytes), 0x00020000)
template <int NT, bool NEXT>
__device__ __forceinline__ void rowwise_residual(Frame& F, const float* x, const Term Ta, const Term Tb, const Term Tc, bf16* H, float* out) {
    const int gw = F.vcu * NWAVES + F.wave, NGW = F.G * NWAVES;
    const auto rx = MKRSRC(x, (size_t)M * DM * 4), ra = MKRSRC(Ta.W, (size_t)M * DM * 2), rb = MKRSRC(Tb.W, (size_t)M * DM * 2), rc = MKRSRC(Tc.W, (size_t)M * DM * 2);
    const auto rh = MKRSRC(NEXT ? (void*)H : (void*)out, NEXT ? (size_t)M * DM * 2 : (size_t)M * DM * 4);
    const int vo16 = F.lane * 16, vo8 = F.lane * 8;
    for (int m = gw; m < M; m += NGW) {
        const float inv0 = 1.f / sqrtf(wave_sum(Ta.SSP[(size_t)m * NSLOT + F.lane]) * (1.f / DM) + EPS);
        float inv1 = 0.f, inv2 = 0.f;
        if constexpr (NT > 1) inv1 = 1.f / sqrtf(wave_sum(Tb.SSP[(size_t)m * NSLOT + F.lane]) * (1.f / DM) + EPS);
        if constexpr (NT > 2) inv2 = 1.f / sqrtf(wave_sum(Tc.SSP[(size_t)m * NSLOT + F.lane]) * (1.f / DM) + EPS);
        f32x4 v[16]; v2i w0[16], w1[16], w2[16];
        const int so4 = m * (DM * 4), so2 = m * (DM * 2);
#pragma unroll
        for (int j = 0; j < 16; ++j) v[j] = __builtin_bit_cast(f32x4, __builtin_amdgcn_raw_buffer_load_b128(rx, vo16 + 1024 * (j & 3), so4 + 4096 * (j >> 2), 0));
#pragma unroll
        for (int j = 0; j < 16; ++j) { w0[j] = __builtin_bit_cast(v2i, __builtin_amdgcn_raw_buffer_load_b64(ra, vo8 + 512 * (j & 7), so2 + 4096 * (j >> 3), 0));
            if constexpr (NT > 1) w1[j] = __builtin_bit_cast(v2i, __builtin_amdgcn_raw_buffer_load_b64(rb, vo8 + 512 * (j & 7), so2 + 4096 * (j >> 3), 0));
            if constexpr (NT > 2) w2[j] = __builtin_bit_cast(v2i, __builtin_amdgcn_raw_buffer_load_b64(rc, vo8 + 512 * (j & 7), so2 + 4096 * (j >> 3), 0)); }
#pragma unroll
        for (int j = 0; j < 16; ++j) {
            { const v2i w = w0[j]; v[j].x += bflo(w.x) * inv0; v[j].y += bfhi(w.x) * inv0; v[j].z += bflo(w.y) * inv0; v[j].w += bfhi(w.y) * inv0; }
            if constexpr (NT > 1) { const v2i w = w1[j]; v[j].x += bflo(w.x) * inv1; v[j].y += bfhi(w.x) * inv1; v[j].z += bflo(w.y) * inv1; v[j].w += bfhi(w.y) * inv1; }
            if constexpr (NT > 2) { const v2i w = w2[j]; v[j].x += bflo(w.x) * inv2; v[j].y += bfhi(w.x) * inv2; v[j].z += bflo(w.y) * inv2; v[j].w += bfhi(w.y) * inv2; }
        }
        if constexpr (NEXT) {
            float s2 = 0.f;
#pragma unroll
            for (int j = 0; j < 16; ++j) s2 += (v[j].x * v[j].x + v[j].y * v[j].y) + (v[j].z * v[j].z + v[j].w * v[j].w);
            const float invn = 1.f / sqrtf(wave_sum(s2) * (1.f / DM) + EPS);
#pragma unroll
            for (int j = 0; j < 16; ++j) { v2u w; w.x = pk2(v[j].x * invn, v[j].y * invn); w.y = pk2(v[j].z * invn, v[j].w * invn);
                __builtin_amdgcn_raw_buffer_store_b64(w, rh, vo8 + 512 * (j & 7), so2 + 4096 * (j >> 3), 0); }
        } else {
#pragma unroll
            for (int j = 0; j < 16; ++j) __builtin_amdgcn_raw_buffer_store_b128(__builtin_bit_cast(v4u, v[j]), rh, vo16 + 1024 * (j & 3), so4 + 4096 * (j >> 2), 0);
        }
    }
}

__device__ __forceinline__ float gelu_tanh_f(float x) {
    const float u = 0.7978845608028654f * (x + 0.044715f * x * x * x);
    return x * __builtin_amdgcn_rcpf(1.0f + __builtin_amdgcn_exp2f(-2.0f * 1.4426950408889634f * u));
}
__device__ __forceinline__ void p9_conv_gelu(Frame& F, const In& I, unsigned char* ws) {
    const bf16* UP = (const bf16*)(ws + WS_UP); bf16* ACT = (bf16*)(ws + WS_ACT);
    constexpr int NCG = DFF / 8, RUN = 32, NRUN = M / RUN;
    const size_t total = (size_t)NRUN * NCG;
    for (size_t it = (size_t)F.vcu * (NWAVES * 64) + F.tid; it < total; it += (size_t)F.G * (NWAVES * 64)) {
        const int run = (int)(it / NCG), cg = (int)(it % NCG), c0 = cg * 8, r0 = run * RUN, t0 = r0 & (SEQ - 1);
        float wg[3][8], wv[3][8], bg[8], bv[8];
#pragma unroll
        for (int k = 0; k < 3; ++k) { const f32x4 a = *(const f32x4*)(I.ffn_cw + (size_t)k * 2 * DFF + c0), b = *(const f32x4*)(I.ffn_cw + (size_t)k * 2 * DFF + c0 + 4);
            const f32x4 c = *(const f32x4*)(I.ffn_cw + (size_t)k * 2 * DFF + DFF + c0), d = *(const f32x4*)(I.ffn_cw + (size_t)k * 2 * DFF + DFF + c0 + 4);
#pragma unroll
            for (int e = 0; e < 4; ++e) { wg[k][e] = a[e]; wg[k][4 + e] = b[e]; wv[k][e] = c[e]; wv[k][4 + e] = d[e]; } }
        { const f32x4 a = *(const f32x4*)(I.ffn_cb + c0), b = *(const f32x4*)(I.ffn_cb + c0 + 4), c = *(const f32x4*)(I.ffn_cb + DFF + c0), d = *(const f32x4*)(I.ffn_cb + DFF + c0 + 4);
#pragma unroll
          for (int e = 0; e < 4; ++e) { bg[e] = a[e]; bg[4 + e] = b[e]; bv[e] = c[e]; bv[4 + e] = d[e]; } }
        float g2[8], g1[8], v2[8], v1[8];
#pragma unroll
        for (int e = 0; e < 8; ++e) { g2[e] = 0.f; g1[e] = 0.f; v2[e] = 0.f; v1[e] = 0.f; }
#define LOAD8(row, off, dst) do { const v4u q_ = *(const GAS v4u*)(UP + (size_t)(row) * (2 * DFF) + (off) + c0); \
        dst[0] = bflo(q_.x); dst[1] = bfhi(q_.x); dst[2] = bflo(q_.y); dst[3] = bfhi(q_.y); dst[4] = bflo(q_.z); dst[5] = bfhi(q_.z); dst[6] = bflo(q_.w); dst[7] = bfhi(q_.w); } while (0)
        if (t0 >= 2) { LOAD8(r0 - 2, 0, g2); LOAD8(r0 - 2, DFF, v2); LOAD8(r0 - 1, 0, g1); LOAD8(r0 - 1, DFF, v1); }
        for (int r = r0; r < r0 + RUN; r += 4) {
            v4u qg[4], qv[4];
#pragma unroll
            for (int q = 0; q < 4; ++q) { qg[q] = *(const GAS v4u*)(UP + (size_t)(r + q) * (2 * DFF) + c0); qv[q] = *(const GAS v4u*)(UP + (size_t)(r + q) * (2 * DFF) + DFF + c0); }
#pragma unroll
            for (int q = 0; q < 4; ++q) {
                float g0[8], v0[8];
                g0[0] = bflo(qg[q].x); g0[1] = bfhi(qg[q].x); g0[2] = bflo(qg[q].y); g0[3] = bfhi(qg[q].y); g0[4] = bflo(qg[q].z); g0[5] = bfhi(qg[q].z); g0[6] = bflo(qg[q].w); g0[7] = bfhi(qg[q].w);
                v0[0] = bflo(qv[q].x); v0[1] = bfhi(qv[q].x); v0[2] = bflo(qv[q].y); v0[3] = bfhi(qv[q].y); v0[4] = bflo(qv[q].z); v0[5] = bfhi(qv[q].z); v0[6] = bflo(qv[q].w); v0[7] = bfhi(qv[q].w);
                float o[8];
#pragma unroll
                for (int e = 0; e < 8; ++e) { const float ug = wg[0][e] * g2[e] + wg[1][e] * g1[e] + wg[2][e] * g0[e] + bg[e]; const float uv = wv[0][e] * v2[e] + wv[1][e] * v1[e] + wv[2][e] * v0[e] + bv[e];
                    o[e] = gelu_tanh_f(ug) * uv; g2[e] = g1[e]; g1[e] = g0[e]; v2[e] = v1[e]; v1[e] = v0[e]; }
                v4u w; w.x = pk2(o[0], o[1]); w.y = pk2(o[2], o[3]); w.z = pk2(o[4], o[5]); w.w = pk2(o[6], o[7]);
                *(GAS v4u*)(ACT + (size_t)(r + q) * DFF + c0) = w;
            }
        }
#undef LOAD8
    }
}
struct Args { In in; float* out; unsigned char* ws; int ph_lo, ph_hi; };
__global__ void __launch_bounds__(NWAVES * 64, 2) fwd_kernel(Args args) {
    extern __shared__ __attribute__((aligned(16))) unsigned char lds[];
    Frame F;
    F.lds = (LAS unsigned char*)lds;
    F.MISC = (volatile LAS unsigned*)(F.lds + MISC_OFF);
    F.tid = threadIdx.x; F.lane = F.tid & 63; F.wave = __builtin_amdgcn_readfirstlane(F.tid >> 6);
    F.G = gridDim.x; { const int bx = blockIdx.x; F.vcu = (F.G % 8 == 0) ? (bx % 8) * (F.G / 8) + bx / 8 : bx; }
    unsigned char* ws = args.ws;
    F.ctl = (gu32*)(ws + WS_CTL);
    const In& I = args.in;
    for (int u = F.tid; u < (LDS_BYTES - LDSCTL_OFF) / 4; u += NWAVES * 64) ((LAS unsigned*)(F.lds + LDSCTL_OFF))[u] = 0u;
    __syncthreads();
#if MK_PER_PHASE
#define GRID_BAR() do { } while (0)
#else
    XcdBarrier bar = xcd_barrier_post((unsigned*)(F.ctl + CW_BAR), F.MISC + 8);
#define GRID_BAR() xcd_barrier(bar)
#endif
    const int lo = args.ph_lo, hi = args.ph_hi;
#ifndef PHMASK
#define PHMASK 0x7fff
#endif
#define IN(k) (((PHMASK >> (k)) & 1) && lo <= (k) && (k) < hi)
#define BOTH(k) (IN(k) && IN((k) + 1))
#ifndef PROBE_REP
#define PROBE_REP 0
#endif
#define REP(k, ...) do { __VA_ARGS__; if ((PROBE_REP >> (k)) & 1) { GRID_BAR(); __VA_ARGS__; } } while (0)
    bf16* const Zb = (bf16*)(ws + WS_Z);
    bf16* const Hb = (bf16*)(ws + WS_H);
    float* const SSP1 = (float*)(ws + WS_SSP1); float* const SSP2 = (float*)(ws + WS_SSP2); float* const SSP3 = (float*)(ws + WS_SSP3);
    const Term T1{(const bf16*)(ws + WS_W1), SSP1}, T2{(const bf16*)(ws + WS_W2), SSP2}, T3{(const bf16*)(ws + WS_GE), SSP3};

    if (IN(0)) { REP(0, p0_prologue(F, I, ws)); if (BOTH(0)) GRID_BAR(); }

    if (IN(1)) {
        pg8::Gemm g{Hb, (const bf16*)(ws + WS_WIN), M, ZC + 256, DM}; pg8::StaticOrder S; S.init(M, ZC + 256, F.G, (int)blockIdx.x);
        pg8::EpiZ E{Zb, ZC, ZT, (float*)(ws + WS_FLT), M};
        REP(1, pg8::gemm_phase<pg8::EpiZ, pg8::StaticOrder, true, true>(F.lds + RING_OFF, g, S, E));
        if (BOTH(1)) GRID_BAR();
    }
    if (IN(2)) { REP(2, p2_conv_scan(F, I, ws)); if (BOTH(2)) GRID_BAR(); }

    if (IN(3)) {
        pg8::Gemm g{(const bf16*)(ws + WS_U), (const bf16*)(ws + WS_WA), M, DM, DM}; pg8::StaticOrder S; S.init(M, DM, F.G, (int)blockIdx.x);
        pg8::EpiGateA E{args.out, DM, Zb + Z_GA, ZC};
        REP(3, pg8::gemm_phase<pg8::EpiGateA, pg8::StaticOrder, true, true>(F.lds + RING_OFF, g, S, E));
    }
    if (IN(4)) {
        REP(4, fox::fox_phase<ZC, DM>((char*)lds + RING_OFF, Zb + Z_Q, Zb + Z_K, Zb + Z_V, (const float*)(ws + WS_NCB), (bf16*)(ws + WS_O), F.G, (int)blockIdx.x));
        if (BOTH(4)) GRID_BAR();
    }
    if (IN(5)) {
        pg8::Gemm g{(const bf16*)(ws + WS_O), (const bf16*)(ws + WS_WB), M, DM, DM}; pg8::StaticOrder S; S.init(M, DM, F.G, (int)blockIdx.x);
        pg8::EpiGateB E{(bf16*)(ws + WS_MM), args.out, DM, Zb + Z_GB, ZC};
        REP(5, pg8::gemm_phase<pg8::EpiGateB, pg8::StaticOrder, true, true>(F.lds + RING_OFF, g, S, E));
        if (BOTH(5)) GRID_BAR();
    }
    if (IN(6)) {
        pg8::Gemm g{(const bf16*)(ws + WS_MM), (const bf16*)(ws + WS_WOUT), M, DM, DM}; pg8::StaticOrder S; S.init(M, DM, F.G, (int)blockIdx.x);
        pg8::EpiSS E{(bf16*)(ws + WS_W1), DM, SSP1, NSLOT, I.g_mix_post};
        REP(6, pg8::gemm_phase<pg8::EpiSS, pg8::StaticOrder, true, true>(F.lds + RING_OFF, g, S, E));
        if (BOTH(6)) GRID_BAR();
    }
    if (IN(7)) { REP(7, rowwise_residual<1, true>(F, I.x, T1, T1, T1, Hb, nullptr)); if (BOTH(7)) GRID_BAR(); }

    if (IN(8)) {
        pg8::Gemm g{Hb, (const bf16*)(ws + WS_WUP), M, 2 * DFF, DM}; pg8::StaticOrder S; S.init(M, 2 * DFF, F.G, (int)blockIdx.x);
        pg8::EpiPlain E{(bf16*)(ws + WS_UP), 2 * DFF};
        REP(8, pg8::gemm_phase<pg8::EpiPlain, pg8::StaticOrder, true, true>(F.lds + RING_OFF, g, S, E));
        if (BOTH(8)) GRID_BAR();
    }
    if (IN(9)) { REP(9, p9_conv_gelu(F, I, ws)); if (BOTH(9)) GRID_BAR(); }

    if (IN(10)) {
        pg8::Gemm g{(const bf16*)(ws + WS_ACT), (const bf16*)(ws + WS_WDN), M, DM, DFF}; pg8::StaticOrder S; S.init(M, DM, F.G, (int)blockIdx.x);
        pg8::EpiSS E{(bf16*)(ws + WS_W2), DM, SSP2, NSLOT, I.g_ffn_post};
        REP(10, pg8::gemm_phase<pg8::EpiSS, pg8::StaticOrder, true, true>(F.lds + RING_OFF, g, S, E));
    }
    if (IN(11)) {
        pg8::Gemm g{(const bf16*)(ws + WS_PB), (const bf16*)(ws + WS_WPLE), M, DM, PLE}; pg8::StaticOrder S; S.init(M, DM, F.G, (int)blockIdx.x);
        pg8::EpiPlain E{(bf16*)(ws + WS_E), DM};
        REP(11, pg8::gemm_phase<pg8::EpiPlain, pg8::StaticOrder, true, true>(F.lds + RING_OFF, g, S, E));
        if (BOTH(11)) GRID_BAR();
    }
    if (IN(12)) { REP(12, rowwise_residual<2, true>(F, I.x, T1, T2, T2, Hb, nullptr)); if (BOTH(12)) GRID_BAR(); }

    if (IN(13)) {
        pg8::Gemm g{Hb, (const bf16*)(ws + WS_WPG), M, DM, DM}; pg8::StaticOrder S; S.init(M, DM, F.G, (int)blockIdx.x);
        pg8::EpiPle E{(bf16*)(ws + WS_GE), DM, (const bf16*)(ws + WS_E), SSP3, NSLOT, I.g_ple_post};
        REP(13, pg8::gemm_phase<pg8::EpiPle, pg8::StaticOrder, true, true>(F.lds + RING_OFF, g, S, E));
        if (BOTH(13)) GRID_BAR();
    }
    if (IN(14)) { REP(14, rowwise_residual<3, false>(F, I.x, T1, T2, T3, nullptr, args.out)); }
#undef IN
#undef BOTH
}

extern "C" void kernel_launch(void* const* d_in, const int* in_sizes, int n_in, void* d_out, int out_size, void* d_ws, size_t ws_size, hipStream_t stream) {
    static int grid = 0;
    if (grid == 0) {
        if (n_in != 20 || in_sizes[0] != M * DM || out_size != M * DM || ws_size < WS_END) { fprintf(stderr, "kernel_launch: shape/workspace mismatch: n_in %d in0 %d out %d ws %zu (need %zu)\n", n_in, n_in > 0 ? in_sizes[0] : -1, out_size, ws_size, (size_t)WS_END); grid = -1; return; }
        int dev = 0, cus = 0, per_cu = 0;
        if (hipGetDevice(&dev) != hipSuccess || hipDeviceGetAttribute(&cus, hipDeviceAttributeMultiprocessorCount, dev) != hipSuccess) { fprintf(stderr, "kernel_launch: device query failed\n"); grid = -1; return; }
        if (hipFuncSetAttribute((const void*)fwd_kernel, hipFuncAttributeMaxDynamicSharedMemorySize, LDS_BYTES) != hipSuccess) { fprintf(stderr, "kernel_launch: hipFuncSetAttribute failed\n"); grid = -1; return; }
        if (hipOccupancyMaxActiveBlocksPerMultiprocessor(&per_cu, (const void*)fwd_kernel, NWAVES * 64, LDS_BYTES) != hipSuccess || per_cu < 1)
            fprintf(stderr, "kernel_launch: note: occupancy query reports %d workgroups per CU\n", per_cu);
        (void)hipGetLastError();
        grid = cus;
    }
    if (grid < 0) return;
    if (hipMemsetAsync((char*)d_ws + WS_CTL, 0, CTL_ZERO_BYTES, stream) != hipSuccess) { fprintf(stderr, "kernel_launch: memset failed\n"); return; }
    Args a{};
    const float** ip = (const float**)&a.in;
    for (int i = 0; i < 20; ++i) ip[i] = (const float*)d_in[i];
    a.out = (float*)d_out; a.ws = (unsigned char*)d_ws;
#if MK_PER_PHASE
    for (int ph = 0; ph < N_PHASES; ++ph) { a.ph_lo = ph; a.ph_hi = ph + 1;
        hipLaunchKernelGGL(fwd_kernel, dim3(grid), dim3(NWAVES * 64), LDS_BYTES, stream, a); }
#else
    a.ph_lo = 0; a.ph_hi = N_PHASES;
    hipLaunchKernelGGL(fwd_kernel, dim3(grid), dim3(NWAVES * 64), LDS_BYTES, stream, a);
#endif
    const hipError_t le = hipPeekAtLastError();
    if (le != hipSuccess) fprintf(stderr, "kernel_launch: launch failed: %s\n", hipGetErrorName(le));
}
```
